# Optimizing an MI355X kernel written in HIP

```python
import jax, jax.numpy as jnp
from jax import lax
import numpy as np

D_MODEL = 2048
BATCH = 8
SEQ = 2048
DEPTH = 4

MEM_LEN = 256
HEAD_DIM = 128
RET_HEADS = 4
RET_WIDTH = RET_HEADS * HEAD_DIM
RET_CHUNK = 128
MLA_HEADS = 4
MLA_NOPE = 128
MLA_ROPE = 64
MLA_V = 128
MLA_Q_RANK = 384
MLA_KV_RANK = 128
MLA_WIDTH = MLA_HEADS * MLA_V
ATTN_BLOCK = 128
MLSTM_HEADS = 4
MLSTM_WIDTH = MLSTM_HEADS * HEAD_DIM
MLSTM_CHUNK = 128
CONV_WIDTH = 4
MEM_HEADS = 4
MEM_WIDTH = MEM_HEADS * HEAD_DIM
MIX_WIDTH = RET_WIDTH + MLA_WIDTH + MLSTM_WIDTH + MEM_WIDTH

ROPE_THETA = 10000.0
LN_EPS = 1e-5
RMS_EPS = 1e-6
DEEPNORM_ALPHA = (2 * DEPTH) ** 0.25
DEEPNORM_BETA = (8 * DEPTH) ** -0.25

IN_SPLITS = (RET_WIDTH, RET_WIDTH, RET_WIDTH,
             MLA_Q_RANK, MLA_KV_RANK, MLA_ROPE,
             MLSTM_WIDTH, MLSTM_WIDTH, MLSTM_WIDTH,
             MLSTM_HEADS, MLSTM_HEADS,
             MEM_WIDTH,
             MIX_WIDTH)
IN_WIDTH = sum(IN_SPLITS)

kernel_name = "hymba_ret_mla_mlstm_deepnorm"


def _split_cols(h, sizes):
    idx = np.cumsum(sizes)[:-1].tolist()
    return jnp.split(h, idx, axis=-1)


def _heads(t, n):
    b, s, _ = t.shape
    return t.reshape(b, s, n, -1).transpose(0, 2, 1, 3)


def _merge(t):
    b, n, s, d = t.shape
    return t.transpose(0, 2, 1, 3).reshape(b, s, n * d)


def _to_chunks(t, size):
    b, h, s = t.shape[:3]
    t = t.reshape(b, h, s // size, size, *t.shape[3:])
    return jnp.moveaxis(t, 2, 0)


def _from_chunks(t):
    n, b, h, size = t.shape[:4]
    return jnp.moveaxis(t, 0, 2).reshape(b, h, n * size, *t.shape[4:])


def _layernorm(x, g, b):
    xf = x.astype(jnp.float32)
    mu = xf.mean(-1, keepdims=True)
    var = jnp.mean(jnp.square(xf - mu), -1, keepdims=True)
    y = (xf - mu) * lax.rsqrt(var + LN_EPS) * g.astype(jnp.float32) + b.astype(jnp.float32)
    return y.astype(x.dtype)


def _rmsnorm(x, g):
    xf = x.astype(jnp.float32)
    y = xf * lax.rsqrt(jnp.mean(jnp.square(xf), -1, keepdims=True) + RMS_EPS) * g.astype(jnp.float32)
    return y.astype(x.dtype)


def _head_norm(h, g):
    n, d = h.shape[1], h.shape[3]
    mu = h.mean(-1, keepdims=True)
    var = jnp.mean(jnp.square(h - mu), -1, keepdims=True)
    return (h - mu) * lax.rsqrt(var + LN_EPS) * g.astype(jnp.float32).reshape(n, 1, d)


def _rope(t, positions):
    half = t.shape[-1] // 2
    freqs = ROPE_THETA ** (-jnp.arange(half, dtype=jnp.float32) / half)
    ang = positions.astype(jnp.float32)[:, None, :, None] * freqs
    cos, sin = jnp.cos(ang), jnp.sin(ang)
    tf = t.astype(jnp.float32)
    t1, t2 = tf[..., :half], tf[..., half:]
    return jnp.concatenate([t1 * cos - t2 * sin, t2 * cos + t1 * sin], -1).astype(t.dtype)


def _retention(q, k, v, positions):
    b, n, s, d = q.shape
    q = _rope(q, positions)
    k = _rope(k, positions) * d ** -0.5
    log_g = jnp.log1p(-jnp.exp2(-5.0 - jnp.arange(n, dtype=jnp.float32)))
    size = RET_CHUNK
    idx = jnp.arange(size, dtype=jnp.float32)
    rel = idx[:, None] - idx[None, :]
    decay_in = jnp.where(rel >= 0, jnp.exp(log_g[:, None, None] * jnp.maximum(rel, 0.0)), 0.0)
    decay_q = jnp.exp(log_g[:, None] * (idx + 1.0))[..., None]
    decay_k = jnp.exp(log_g[:, None] * (size - 1.0 - idx))[..., None]
    decay_chunk = jnp.exp(log_g * size)[:, None, None]

    def step(state, inp):
        qc, kc, vc = inp
        sc = jnp.einsum('bhqd,bhkd->bhqk', qc, kc) * decay_in
        out = jnp.einsum('bhqk,bhkd->bhqd', sc, vc) + jnp.einsum('bhqd,bhde->bhqe', qc, state) * decay_q
        state = decay_chunk * state + jnp.einsum('bhkd,bhke->bhde', kc * decay_k, vc)
        return state, out

    state0 = jnp.zeros((b, n, d, v.shape[-1]), jnp.float32)
    _, out = lax.scan(step, state0, (_to_chunks(q, size), _to_chunks(k, size), _to_chunks(v, size)))
    return _from_chunks(out)


def _causal_attention(q, k, v):
    b, n, s, d = q.shape
    nb = s // ATTN_BLOCK
    qb = jnp.moveaxis(q.reshape(b, n, nb, ATTN_BLOCK, d), 2, 0)
    kpos = jnp.arange(s)

    def one_block(args):
        qblk, bi = args
        sc = jnp.einsum('bhqd,bhkd->bhqk', qblk, k).astype(jnp.float32)
        qpos = bi * ATTN_BLOCK + jnp.arange(ATTN_BLOCK)
        sc = jnp.where(kpos[None, :] <= qpos[:, None], sc, -jnp.inf)
        p = jax.nn.softmax(sc, axis=-1).astype(v.dtype)
        return jnp.einsum('bhqk,bhkd->bhqd', p, v)

    out = lax.map(one_block, (qb, jnp.arange(nb)))
    return _from_chunks(out)


def _mla(c_q, c_kv, k_pe, q_norm_g, w_uq, kv_norm_g, w_ukv, positions):
    b, s, _ = c_q.shape
    q = (_rmsnorm(c_q, q_norm_g) @ w_uq).reshape(b, s, MLA_HEADS, MLA_NOPE + MLA_ROPE).transpose(0, 2, 1, 3)
    q = jnp.concatenate([q[..., :MLA_NOPE], _rope(q[..., MLA_NOPE:], positions)], -1)
    kv = (_rmsnorm(c_kv, kv_norm_g) @ w_ukv).reshape(b, s, MLA_HEADS, MLA_NOPE + MLA_V).transpose(0, 2, 1, 3)
    k_rot = _rope(k_pe[:, None], positions)
    k = jnp.concatenate([kv[..., :MLA_NOPE], jnp.broadcast_to(k_rot, (b, MLA_HEADS, s, MLA_ROPE))], -1)
    v = kv[..., MLA_NOPE:]
    return _causal_attention(q * (MLA_NOPE + MLA_ROPE) ** -0.5, k, v)


def _causal_conv(t, w, bias):
    kw, c = w.shape
    tp = jnp.pad(t, ((0, 0), (kw - 1, 0), (0, 0)))
    y = lax.conv_general_dilated(tp, w[:, None, :], window_strides=(1,), padding='VALID',
                                 dimension_numbers=('NWC', 'WIO', 'NWC'), feature_group_count=c)
    return y + bias


def _mlstm(q, k, v, i_pre, f_pre):
    b, n, s, d = q.shape
    size = MLSTM_CHUNK
    k = k * d ** -0.5
    log_f = jax.nn.log_sigmoid(f_pre)
    causal = jnp.tril(jnp.ones((size, size), bool))

    def step(carry, inp):
        c_st, n_st, m_st = carry
        qc, kc, vc, ic, fc = inp
        cum = jnp.cumsum(fc, -1)
        log_d = jnp.where(causal, cum[..., :, None] - cum[..., None, :] + ic[..., None, :], -jnp.inf)
        inter = cum + m_st[..., None]
        m_t = jnp.maximum(inter, log_d.max(-1))
        sc = jnp.einsum('bhqd,bhkd->bhqk', qc, kc) * jnp.exp(log_d - m_t[..., None])
        w_inter = jnp.exp(inter - m_t)
        num = jnp.einsum('bhqk,bhkd->bhqd', sc, vc) + w_inter[..., None] * jnp.einsum('bhqd,bhde->bhqe', qc, c_st)
        den = sc.sum(-1) + w_inter * jnp.einsum('bhqd,bhd->bhq', qc, n_st)
        h = num / jnp.maximum(jnp.abs(den), jnp.exp(-m_t))[..., None]
        cum_last = cum[..., -1]
        log_wk = cum_last[..., None] - cum + ic
        m_new = jnp.maximum(cum_last + m_st, log_wk.max(-1))
        wk = jnp.exp(log_wk - m_new[..., None])
        decay = jnp.exp(cum_last + m_st - m_new)
        c_st = decay[..., None, None] * c_st + jnp.einsum('bhkd,bhke->bhde', kc * wk[..., None], vc)
        n_st = decay[..., None] * n_st + jnp.einsum('bhkd,bhk->bhd', kc, wk)
        return (c_st, n_st, m_new), h

    carry0 = (jnp.zeros((b, n, d, v.shape[-1]), jnp.float32), jnp.zeros((b, n, d), jnp.float32),
              jnp.zeros((b, n), jnp.float32))
    _, h = lax.scan(step, carry0, (_to_chunks(q, size), _to_chunks(k, size), _to_chunks(v, size),
                                   _to_chunks(i_pre, size), _to_chunks(log_f, size)))
    return _from_chunks(h)


def _mem_attention(q, mem, w_mem_kv):
    k, v = jnp.split(mem @ w_mem_kv, 2, axis=-1)
    qh = _heads(q, MEM_HEADS) * HEAD_DIM ** -0.5
    kh, vh = _heads(k, MEM_HEADS), _heads(v, MEM_HEADS)
    sc = jnp.einsum('bhqd,bhkd->bhqk', qh, kh).astype(jnp.float32)
    p = jax.nn.softmax(sc, axis=-1).astype(vh.dtype)
    return jnp.einsum('bhqk,bhkd->bhqd', p, vh)


def _layer(x, mem, positions, w_in, ret_norm_g, mla_q_norm_g, mla_w_uq, mla_kv_norm_g, mla_w_ukv,
           ml_conv_w, ml_conv_b, ml_w_q, ml_w_k, ml_i_bias, ml_f_bias, ml_skip, ml_norm_g,
           w_mem_kv, w_out, ln_g, ln_b):
    f32 = jnp.float32
    b, s, _ = x.shape
    (r_q, r_k, r_v, a_cq, a_ckv, a_kpe, l_x, l_v, l_o, l_i, l_f, c_q, z) = _split_cols(x @ w_in, IN_SPLITS)

    ret = _retention(_heads(r_q, RET_HEADS).astype(f32), _heads(r_k, RET_HEADS).astype(f32),
                     _heads(r_v, RET_HEADS).astype(f32), positions)
    ret = _merge(_head_norm(ret, ret_norm_g))

    mla = _merge(_mla(a_cq, a_ckv, a_kpe, mla_q_norm_g, mla_w_uq, mla_kv_norm_g, mla_w_ukv,
                      positions)).astype(f32)

    xc = jax.nn.silu(_causal_conv(l_x, ml_conv_w, ml_conv_b))
    xc_h = xc.reshape(b, s, MLSTM_HEADS, HEAD_DIM)
    lq = jnp.einsum('bshd,hde->bhse', xc_h, ml_w_q).astype(f32)
    lk = jnp.einsum('bshd,hde->bhse', xc_h, ml_w_k).astype(f32)
    lv = _heads(l_v, MLSTM_HEADS).astype(f32)
    i_pre = jnp.swapaxes(l_i + ml_i_bias, 1, 2).astype(f32)
    f_pre = jnp.swapaxes(l_f + ml_f_bias, 1, 2).astype(f32)
    cell = _mlstm(lq, lk, lv, i_pre, f_pre) * jax.nn.sigmoid(_heads(l_o, MLSTM_HEADS).astype(f32))
    mls = _merge(_head_norm(cell, ml_norm_g)) + ml_skip.astype(f32) * xc.astype(f32)

    memo = _merge(_mem_attention(c_q, mem, w_mem_kv)).astype(f32)

    y = jnp.concatenate([ret, mla, mls, memo], axis=-1) * jax.nn.silu(z.astype(f32))
    y = y.astype(x.dtype) @ w_out
    return _layernorm(DEEPNORM_ALPHA * x + y, ln_g, ln_b)


def setup_inputs(seed: int = 0) -> dict:
    key = jax.random.key(seed)
    ks = jax.random.split(key, 24)
    f32 = jnp.float32

    def nrm(k, shape, std):
        return jax.random.normal(k, shape, f32) * std

    def gain(k, shape):
        return 1.0 + 0.02 * jax.random.normal(k, shape, f32)

    L = DEPTH
    return {
        "x": nrm(ks[0], (BATCH, SEQ, D_MODEL), 1.0),
        "mem": nrm(ks[1], (BATCH, MEM_LEN, D_MODEL), 1.0),
        "positions": jnp.tile(jnp.arange(SEQ, dtype=jnp.int32)[None, :], (BATCH, 1)),
        "w_in": nrm(ks[2], (L, D_MODEL, IN_WIDTH), D_MODEL ** -0.5),
        "ret_norm_g": gain(ks[3], (L, RET_WIDTH)),
        "mla_q_norm_g": gain(ks[4], (L, MLA_Q_RANK)),
        "mla_w_uq": nrm(ks[5], (L, MLA_Q_RANK, MLA_HEADS * (MLA_NOPE + MLA_ROPE)), MLA_Q_RANK ** -0.5),
        "mla_kv_norm_g": gain(ks[6], (L, MLA_KV_RANK)),
        "mla_w_ukv": nrm(ks[7], (L, MLA_KV_RANK, MLA_HEADS * (MLA_NOPE + MLA_V)), MLA_KV_RANK ** -0.5),
        "ml_conv_w": nrm(ks[8], (L, CONV_WIDTH, MLSTM_WIDTH), CONV_WIDTH ** -0.5),
        "ml_conv_b": nrm(ks[9], (L, MLSTM_WIDTH), 0.02),
        "ml_w_q": nrm(ks[10], (L, MLSTM_HEADS, HEAD_DIM, HEAD_DIM), HEAD_DIM ** -0.5),
        "ml_w_k": nrm(ks[11], (L, MLSTM_HEADS, HEAD_DIM, HEAD_DIM), HEAD_DIM ** -0.5),
        "ml_i_bias": nrm(ks[12], (L, MLSTM_HEADS), 0.1),
        "ml_f_bias": jnp.linspace(3.0, 6.0, MLSTM_HEADS, dtype=f32)[None, :] + nrm(ks[13], (L, MLSTM_HEADS), 0.1),
        "ml_skip": gain(ks[14], (L, MLSTM_WIDTH)),
        "ml_norm_g": gain(ks[15], (L, MLSTM_WIDTH)),
        "w_mem_kv": nrm(ks[16], (L, D_MODEL, 2 * MEM_WIDTH), D_MODEL ** -0.5),
        "w_out": nrm(ks[17], (L, MIX_WIDTH, D_MODEL), DEEPNORM_BETA * MIX_WIDTH ** -0.5),
        "ln_g": gain(ks[18], (L, D_MODEL)),
        "ln_b": nrm(ks[19], (L, D_MODEL), 0.02),
    }


def reference(x, mem, positions, w_in, ret_norm_g, mla_q_norm_g, mla_w_uq, mla_kv_norm_g, mla_w_ukv,
              ml_conv_w, ml_conv_b, ml_w_q, ml_w_k, ml_i_bias, ml_f_bias, ml_skip, ml_norm_g,
              w_mem_kv, w_out, ln_g, ln_b):
    for l in range(DEPTH):
        x = _layer(x, mem, positions, w_in[l], ret_norm_g[l], mla_q_norm_g[l], mla_w_uq[l],
                   mla_kv_norm_g[l], mla_w_ukv[l], ml_conv_w[l], ml_conv_b[l], ml_w_q[l], ml_w_k[l],
                   ml_i_bias[l], ml_f_bias[l], ml_skip[l], ml_norm_g[l], w_mem_kv[l], w_out[l],
                   ln_g[l], ln_b[l])
    return x
```

```cpp
#include <hip/hip_runtime.h>
#include <hip/hip_cooperative_groups.h>
#include <cstdio>
namespace cg = cooperative_groups;
namespace pg8 {
#define PG8_LAS __attribute__((address_space(3)))
typedef unsigned short bf16_t;
typedef short bf16x8 __attribute__((ext_vector_type(8)));
typedef float f32x4 __attribute__((ext_vector_type(4)));
typedef unsigned u32x4 __attribute__((ext_vector_type(4)));
constexpr int BM = 256, BK = 64, HALF = 128, HTB = HALF * BK * 2  , STAGE_BYTES = 8 * HTB, NXCD = 8, WGM = 8;

__host__ __device__ __forceinline__ int lds_byte(int r, int c) { const int st = (r >> 4) * 2 + (c >> 5), rr = r & 15, cc = c & 31, ob = rr * 64 + cc * 2; return st * 1024 + (ob ^ (((ob >> 9) & 1) << 5)); }
__host__ __device__ __forceinline__ void stage_rc(int b, int& R, int& C) { const int st = b / 1024, sb = b % 1024, swz = sb ^ (((sb >> 9) & 1) << 5); R = (st >> 1) * 16 + swz / 64; C = (st & 1) * 32 + (swz % 64) / 2; }
__host__ __device__ __forceinline__ int perm32(int rho) { const int n = rho >> 4, i = rho & 15; return 8 * (i >> 2) + 4 * n + (i & 3); }

struct Unit { int pm, pn; };
struct Gemm { const bf16_t* A; const bf16_t* Bt; int M, N, K; };

struct StaticOrder {
    int nM, nN, nwg, G, c;
    __host__ __device__ void init(int M, int N, int G_, int c_) { nM = M / BM; nN = N / BM; nwg = nM * nN; G = G_; c = c_; }
    __host__ __device__ bool next(int i, Unit& u) const {
        const long L = (long)i * G + c; if (L >= nwg) return false;
        int wgid = (int)L; { const int q = nwg / NXCD, r = nwg % NXCD, xcd = wgid % NXCD, off = wgid / NXCD; wgid = (xcd < r ? xcd * (q + 1) : r * (q + 1) + (xcd - r) * q) + off; }
        const int nig = WGM * nN, gid = wgid / nig, fm = gid * WGM, gsz = (nM - fm) < WGM ? (nM - fm) : WGM;
        u.pm = fm + ((wgid % nig) % gsz); u.pn = (wgid % nig) / gsz; return true;
    }
    __device__ __forceinline__ void a_ready(const Unit&) const {}
    __device__ __forceinline__ void done(const Unit&) const {}
};
__device__ __forceinline__ unsigned cvt_pk_bf16(float lo, float hi) { unsigned r; asm volatile("v_cvt_pk_bf16_f32 %0, %1, %2" : "=v"(r) : "v"(lo), "v"(hi)); return r; }
typedef float f32x2 __attribute__((ext_vector_type(2)));
__device__ __forceinline__ f32x2 gelu_pk(f32x2 v) {
    const f32x2 av = __builtin_elementwise_abs(v), d = av * 0.2316418882f + 1.0f;
    f32x2 t; t.x = __builtin_amdgcn_rcpf(d.x); t.y = __builtin_amdgcn_rcpf(d.y);
    f32x2 q = t * 0.5307027145f + (-0.7265760135f); q = q * t + 0.7107068705f; q = q * t + (-0.142248368f); q = q * t + 0.127414796f; q = q * t;
    const f32x2 s = (v * v) * (-0.72134752044f);
    f32x2 e; e.x = __builtin_amdgcn_exp2f(s.x); e.y = __builtin_amdgcn_exp2f(s.y);
    const f32x2 m = v * (q * e), r = v - m;
    f32x2 o; o.x = v.x < 0.f ? m.x : r.x; o.y = v.y < 0.f ? m.y : r.y; return o;
}
template <int ACT  > struct EpiBf16 {
    static constexpr bool PERM = true, AFTER_DRAIN = false;
    bf16_t* O; int ldc; const float* bias; int split_cols; size_t split_stride;
    __device__ __forceinline__ void operator()(const f32x4 (&acc)[2][2][4][2], const Unit& u, int wr, int wc, int fr, int fq) const {
        const int row0 = u.pm * BM + wr * 64 + fr; int colt = u.pn * BM; bf16_t* base = O;
        if (split_cols) { const int t = colt / split_cols; base += (size_t)t * split_stride; colt -= t * split_cols; }
        const int col0 = colt + wc * 32 + 8 * fq, bcol0 = u.pn * BM + wc * 32 + 8 * fq;
        f32x4 bv[2][2];
#pragma unroll
        for (int bj = 0; bj < 2; ++bj)
#pragma unroll
            for (int n = 0; n < 2; ++n) bv[bj][n] = bias ? *(const f32x4*)(bias + bcol0 + bj * HALF + 4 * n) : (f32x4){0.f, 0.f, 0.f, 0.f};
#pragma unroll
        for (int ai = 0; ai < 2; ++ai)
#pragma unroll
            for (int m = 0; m < 4; ++m) { bf16_t* rowp = base + (size_t)(row0 + ai * HALF + m * 16) * ldc + col0;
#pragma unroll
                for (int bj = 0; bj < 2; ++bj) { f32x4 v0 = acc[ai][bj][m][0] + bv[bj][0], v1 = acc[ai][bj][m][1] + bv[bj][1];
                    if (ACT == 1) { f32x2 a = gelu_pk((f32x2){v0[0], v0[1]}), b = gelu_pk((f32x2){v0[2], v0[3]}), c = gelu_pk((f32x2){v1[0], v1[1]}), d = gelu_pk((f32x2){v1[2], v1[3]});
                        v0 = (f32x4){a.x, a.y, b.x, b.y}; v1 = (f32x4){c.x, c.y, d.x, d.y}; }
                    if (ACT == 2) {
#pragma unroll
                        for (int j = 0; j < 4; ++j) { v0[j] = 0.5f * v0[j] * (1.0f + erff(v0[j] * 0.70710678f)); v1[j] = 0.5f * v1[j] * (1.0f + erff(v1[j] * 0.70710678f)); } }
                    u32x4 w; w.x = cvt_pk_bf16(v0[0], v0[1]); w.y = cvt_pk_bf16(v0[2], v0[3]); w.z = cvt_pk_bf16(v1[0], v1[1]); w.w = cvt_pk_bf16(v1[2], v1[3]);
                    *(u32x4*)(rowp + bj * HALF) = w; } }
    }
};
template <class Epi, class Sched, bool STAMP = false>
__device__ __forceinline__ void gemm_phase(PG8_LAS unsigned char* lds, const Gemm g, const Sched& S, const Epi& E, unsigned long long* stamps) {
    const int tid = threadIdx.x, wid = __builtin_amdgcn_readfirstlane(tid >> 6), lane = tid & 63, wr = wid >> 2, wc = wid & 3, fr = lane & 15, fq = lane >> 4;
    const int K = g.K, nt = K / BK;
    int ts_lo = 0, ts_hi = 0, nts = 0; const unsigned long long rt_entry = STAMP ? (unsigned long long)wall_clock64() : 0ull;
#define PG8_STAMP() do { if (STAMP && wid == 0 && nts < 64) { const unsigned long long _c = (unsigned long long)clock64(); \
        ts_lo = (lane == nts) ? (int)(unsigned)_c : ts_lo; ts_hi = (lane == nts) ? (int)(unsigned)(_c >> 32) : ts_hi; ++nts; } } while (0)
    PG8_STAMP();
    unsigned voffA[2], voffB[2];
#pragma unroll
    for (int i = 0; i < 2; ++i) { int R, C; stage_rc(tid * 16 + i * 8192, R, C); const int Rb = Epi::PERM ? ((R & ~31) + perm32(R & 31)) : R;
        voffA[i] = (unsigned)(R * K + C) * 2u; voffB[i] = (unsigned)(Rb * K + C) * 2u; }
    const size_t kstep = (size_t)(BK * 2);
    const size_t hstep = (size_t)HALF * K * 2;
    const size_t tstep = 2 * hstep;
    const unsigned ldsw = (unsigned)wid * 1024u;
    const int aoff = lds_byte(wr * 64 + fr, fq * 8), boff = lds_byte(wc * 32 + fr, fq * 8);
#define PG8_SA(b, h) (((b) * 2 + (h)) * HTB)
#define PG8_SB(b, h) ((4 + (b) * 2 + (h)) * HTB)
#define PG8_STAGE(bufoff, gbase, voff) do { _Pragma("unroll") for (int _i = 0; _i < 2; ++_i) \
        __builtin_amdgcn_global_load_lds((const unsigned*)((const char*)(gbase) + (voff)[_i]), (PG8_LAS unsigned*)(lds + (bufoff) + ldsw + _i * 8192), 16, 0, 0); } while (0)
#define PG8_LDA(dst, b, h) do { _Pragma("unroll") for (int m = 0; m < 4; ++m) _Pragma("unroll") for (int k = 0; k < 2; ++k) dst[m][k] = *(const PG8_LAS bf16x8*)(lds + PG8_SA(b, h) + aoff + m * 2048 + k * 1024); } while (0)
#define PG8_LDB(dst, b, h) do { _Pragma("unroll") for (int n = 0; n < 2; ++n) _Pragma("unroll") for (int k = 0; k < 2; ++k) dst[n][k] = *(const PG8_LAS bf16x8*)(lds + PG8_SB(b, h) + boff + n * 2048 + k * 1024); } while (0)
#define PG8_MMA(ai, bj, At, Bt) do { __builtin_amdgcn_s_setprio(1); _Pragma("unroll") for (int m = 0; m < 4; ++m) _Pragma("unroll") for (int n = 0; n < 2; ++n) _Pragma("unroll") for (int k = 0; k < 2; ++k) \
        acc[ai][bj][m][n] = __builtin_amdgcn_mfma_f32_16x16x32_bf16(Bt[n][k], At[m][k], acc[ai][bj][m][n], 0, 0, 0); __builtin_amdgcn_s_setprio(0); } while (0)
#define PG8_WAIT_V(n) asm volatile("s_waitcnt vmcnt(" #n ")" ::: "memory")
#define PG8_WAIT_L(n) asm volatile("s_waitcnt lgkmcnt(" #n ")" ::: "memory")
#define PG8_BAR __builtin_amdgcn_s_barrier()
#define PG8_SCHED __builtin_amdgcn_sched_barrier(0)
    Unit cur, nxt; int ui = 0;
    if (!S.next(0, cur)) return;
    f32x4 acc[2][2][4][2];
#pragma unroll
    for (int a = 0; a < 2; ++a)
#pragma unroll
        for (int b = 0; b < 2; ++b)
#pragma unroll
            for (int m = 0; m < 4; ++m)
#pragma unroll
                for (int n = 0; n < 2; ++n) acc[a][b][m][n] = (f32x4){0.f, 0.f, 0.f, 0.f};
    bf16x8 At[4][2], B0[2][2], B1[2][2];
    const char* cA = (const char*)g.A + (size_t)cur.pm * tstep; const char* cB = (const char*)g.Bt + (size_t)cur.pn * tstep;
    S.a_ready(cur);
    PG8_STAGE(PG8_SB(0, 0), cB, voffB); PG8_STAGE(PG8_SA(0, 0), cA, voffA); PG8_STAGE(PG8_SB(0, 1), cB + hstep, voffB); PG8_STAGE(PG8_SA(0, 1), cA + hstep, voffA);
    if (wr == 1) PG8_BAR;
    PG8_WAIT_V(4); PG8_BAR;
    PG8_STAGE(PG8_SB(1, 0), cB + kstep, voffB); PG8_STAGE(PG8_SA(1, 0), cA + kstep, voffA); PG8_STAGE(PG8_SB(1, 1), cB + hstep + kstep, voffB);
    PG8_WAIT_V(6); PG8_BAR;
    PG8_STAMP();
    for (;;) {
        const bool has_next = S.next(ui + 1, nxt);
        const char* nA = has_next ? (const char*)g.A + (size_t)nxt.pm * tstep : cA; const char* nB = has_next ? (const char*)g.Bt + (size_t)nxt.pn * tstep : cB;
        for (int t = 0; t < nt; t += 2) {
            const bool last = (t == nt - 2);
            const char* a1 = cA + (size_t)(t + 1) * kstep;
            const char* a2 = last ? nA : cA + (size_t)(t + 2) * kstep; const char* b2 = last ? nB : cB + (size_t)(t + 2) * kstep;
            const char* a3 = a2 + kstep; const char* b3 = b2 + kstep;
            if (last && has_next) S.a_ready(nxt);
            PG8_LDB(B0, 0, 0); PG8_SCHED; PG8_LDA(At, 0, 0); PG8_STAGE(PG8_SA(1, 1), a1 + hstep, voffA);
            PG8_WAIT_L(8); PG8_BAR; PG8_WAIT_L(0); PG8_MMA(0, 0, At, B0); PG8_BAR; PG8_SCHED;
            PG8_LDB(B1, 0, 1); PG8_STAGE(PG8_SB(0, 0), b2, voffB);
            PG8_BAR; PG8_WAIT_L(0); PG8_MMA(0, 1, At, B1); PG8_BAR;
            PG8_LDA(At, 0, 1); PG8_STAGE(PG8_SA(0, 0), a2, voffA);
            PG8_BAR; PG8_WAIT_L(0); PG8_MMA(1, 0, At, B0); PG8_BAR; PG8_SCHED;
            PG8_STAGE(PG8_SB(0, 1), b2 + hstep, voffB);
            PG8_WAIT_V(6); PG8_BAR; PG8_MMA(1, 1, At, B1); PG8_BAR;
            PG8_LDB(B0, 1, 0); PG8_SCHED; PG8_LDA(At, 1, 0); PG8_STAGE(PG8_SA(0, 1), a2 + hstep, voffA);
            PG8_WAIT_L(8); PG8_BAR; PG8_WAIT_L(0); PG8_MMA(0, 0, At, B0); PG8_BAR; PG8_SCHED;
            PG8_LDB(B1, 1, 1); PG8_STAGE(PG8_SB(1, 0), b3, voffB);
            PG8_BAR; PG8_WAIT_L(0); PG8_MMA(0, 1, At, B1); PG8_BAR;
            PG8_LDA(At, 1, 1); PG8_STAGE(PG8_SA(1, 0), a3, voffA);
            PG8_BAR; PG8_WAIT_L(0); PG8_MMA(1, 0, At, B0); PG8_BAR; PG8_SCHED;
            PG8_STAGE(PG8_SB(1, 1), b3 + hstep, voffB);
            PG8_WAIT_V(6); PG8_BAR; PG8_MMA(1, 1, At, B1); PG8_BAR;
        }
        PG8_STAMP();
        if constexpr (!Epi::AFTER_DRAIN) { E(acc, cur, wr, wc, fr, fq); S.done(cur); }
        PG8_STAMP();
        if (!has_next) break;
#pragma unroll
        for (int a = 0; a < 2; ++a)
#pragma unroll
            for (int b = 0; b < 2; ++b)
#pragma unroll
                for (int m = 0; m < 4; ++m)
#pragma unroll
                    for (int n = 0; n < 2; ++n) acc[a][b][m][n] = (f32x4){0.f, 0.f, 0.f, 0.f};
        cur = nxt; cA = nA; cB = nB; ++ui;
    }
    PG8_WAIT_V(0);
    if (wr == 0) PG8_BAR;
    PG8_BAR;
    if constexpr (Epi::AFTER_DRAIN) { E.fused(acc, cur, wr, wc, fr, fq, lds, wid, lane); S.done(cur); }
    PG8_STAMP();
    if (STAMP && wid == 0) { stamps[lane] = lane < nts ? (((unsigned long long)(unsigned)ts_hi << 32) | (unsigned)ts_lo) : 0ull;
        if (lane == 62) stamps[62] = rt_entry; if (lane == 63) stamps[63] = (unsigned long long)wall_clock64(); }
#undef PG8_STAMP
#undef PG8_SA
#undef PG8_SB
#undef PG8_STAGE
#undef PG8_LDA
#undef PG8_LDB
#undef PG8_MMA
#undef PG8_WAIT_V
#undef PG8_WAIT_L
#undef PG8_BAR
#undef PG8_SCHED
}
}

#ifndef N_LAUNCH_MODE
#define N_LAUNCH_MODE 1
#endif
#define LAS __attribute__((address_space(3)))
typedef unsigned short bf16_t;
typedef short bf16x8 __attribute__((ext_vector_type(8)));
typedef float f32x4 __attribute__((ext_vector_type(4)));
typedef unsigned u32x4 __attribute__((ext_vector_type(4)));
typedef unsigned u32x2 __attribute__((ext_vector_type(2)));

constexpr int NTOK = 16384, DM = 2048, SEQ = 2048, NB = 8, DEPTH = 4;
constexpr int HLD = 6144;
constexpr int NIN = 6400;
constexpr int C_RQ = 0, C_RK = 512, C_RV = 1024, C_ACQ = 1536, C_ACKV = 1920, C_LX = 2048, C_LV = 2560, C_LO = 3072, C_CQ = 3584, C_Z = 4096;
constexpr int S_KPE = 0, S_LI = 64, S_LF = 68;
constexpr int TS = 136, TS2 = 200;
constexpr int REG = 128 * TS * 2;
constexpr int MISC_OFF = 4 * REG;
constexpr int LDS_BYTES = MISC_OFF + 4096;
constexpr int NPHASE = 1 + 5 * DEPTH;

constexpr size_t AL(size_t x) { return (x + 255) & ~(size_t)255; }
constexpr size_t WS_WIN = 0;
constexpr size_t WS_WOUT = WS_WIN + AL((size_t)DEPTH * NIN * DM * 2);
constexpr size_t WS_WMEM = WS_WOUT + AL((size_t)DEPTH * DM * DM * 2);
constexpr size_t WS_WUQ = WS_WMEM + AL((size_t)DEPTH * 1024 * DM * 2);
constexpr size_t WS_WUKV = WS_WUQ + AL((size_t)DEPTH * 768 * 384 * 2);
constexpr size_t WS_WQ = WS_WUKV + AL((size_t)DEPTH * 1024 * 128 * 2);
constexpr size_t WS_WK = WS_WQ + AL((size_t)DEPTH * 4 * 128 * 128 * 2);
constexpr size_t WS_XN = WS_WK + AL((size_t)DEPTH * 4 * 128 * 128 * 2);
constexpr size_t WS_MEMB = WS_XN + AL((size_t)NTOK * DM * 2);
constexpr size_t WS_H = WS_MEMB + AL((size_t)2048 * DM * 2);
constexpr size_t WS_HS = WS_H + AL((size_t)NTOK * HLD * 2);
constexpr size_t WS_MKV = WS_HS + AL((size_t)NTOK * 256 * 4);
constexpr size_t WS_URT = WS_MKV + AL((size_t)2048 * 1024 * 2);
constexpr size_t WS_ULT = WS_URT + AL((size_t)512 * 16384 * 2);
constexpr size_t WS_NV = WS_ULT + AL((size_t)512 * 16384 * 2);
constexpr size_t WS_GSC = WS_NV + AL((size_t)512 * 128 * 4);
constexpr size_t WS_LQ = WS_GSC + AL((size_t)512 * 2 * 4);
constexpr size_t WS_LK = WS_LQ + AL((size_t)NTOK * 512 * 2);
constexpr size_t WS_XC = WS_LK + AL((size_t)NTOK * 512 * 2);
constexpr size_t WS_QA = WS_XC + AL((size_t)NTOK * 512 * 2);
constexpr size_t WS_KA = WS_QA + AL((size_t)NTOK * 4 * 192 * 2);
constexpr size_t WS_VAT = WS_KA + AL((size_t)NTOK * 4 * 192 * 2);
constexpr size_t WS_Y = WS_VAT + AL((size_t)NTOK * 512 * 2);
constexpr size_t WS_END = WS_Y + AL((size_t)NTOK * DM * 2);

struct Prm {
    const float* x; const float* mem; const int* pos;
    const float* w_in; const float* ret_norm_g; const float* mla_q_norm_g; const float* mla_w_uq; const float* mla_kv_norm_g; const float* mla_w_ukv;
    const float* ml_conv_w; const float* ml_conv_b; const float* ml_w_q; const float* ml_w_k; const float* ml_i_bias; const float* ml_f_bias; const float* ml_skip; const float* ml_norm_g;
    const float* w_mem_kv; const float* w_out; const float* ln_g; const float* ln_b;
    float* out; unsigned char* ws;
    int ph_lo, ph_hi;
};

__device__ __forceinline__ float bf2f(bf16_t b) { return __uint_as_float(((unsigned)b) << 16); }
__device__ __forceinline__ bf16_t f2bf(float f) { unsigned u = __float_as_uint(f); u += 0x7FFFu + ((u >> 16) & 1u); return (bf16_t)(u >> 16); }
__device__ __forceinline__ unsigned pk2(float lo, float hi) { return pg8::cvt_pk_bf16(lo, hi); }
__device__ __forceinline__ float lo16(unsigned w) { return __uint_as_float(w << 16); }
__device__ __forceinline__ float hi16(unsigned w) { return __uint_as_float(w & 0xffff0000u); }
__device__ __forceinline__ float siluf(float v) { return v / (1.0f + __expf(-v)); }
__device__ __forceinline__ float sigmf(float v) { return 1.0f / (1.0f + __expf(-v)); }
__device__ __forceinline__ float rsum4(float v) { v += __shfl_xor(v, 16); v += __shfl_xor(v, 32); return v; }
__device__ __forceinline__ float rmax4(float v) { v = fmaxf(v, __shfl_xor(v, 16)); v = fmaxf(v, __shfl_xor(v, 32)); return v; }

struct EpiH {
    static constexpr bool PERM = true, AFTER_DRAIN = false;
    bf16_t* H; float* HS;
    __device__ __forceinline__ void operator()(const pg8::f32x4 (&acc)[2][2][4][2], const pg8::Unit& u, int wr, int wc, int fr, int fq) const {
        const int row0 = u.pm * 256 + wr * 64 + fr;
        if (u.pn < 24) {
            const int col0 = u.pn * 256 + wc * 32 + 8 * fq;
#pragma unroll
            for (int ai = 0; ai < 2; ++ai)
#pragma unroll
                for (int m = 0; m < 4; ++m) { bf16_t* rowp = H + (size_t)(row0 + ai * 128 + m * 16) * HLD + col0;
#pragma unroll
                    for (int bj = 0; bj < 2; ++bj) { const pg8::f32x4 v0 = acc[ai][bj][m][0], v1 = acc[ai][bj][m][1];
                        u32x4 w; w.x = pk2(v0[0], v0[1]); w.y = pk2(v0[2], v0[3]); w.z = pk2(v1[0], v1[1]); w.w = pk2(v1[2], v1[3]);
                        *(u32x4*)(rowp + bj * 128) = w; } }
        } else {
            const int col0 = wc * 32 + 8 * fq;
#pragma unroll
            for (int ai = 0; ai < 2; ++ai)
#pragma unroll
                for (int m = 0; m < 4; ++m) { float* rowp = HS + (size_t)(row0 + ai * 128 + m * 16) * 256 + col0;
#pragma unroll
                    for (int bj = 0; bj < 2; ++bj)
#pragma unroll
                        for (int n = 0; n < 2; ++n) *(pg8::f32x4*)(rowp + bj * 128 + 4 * n) = acc[ai][bj][m][n]; }
        }
    }
};
struct EpiRes {
    static constexpr bool PERM = false, AFTER_DRAIN = false;
    const float* X; float* T; float alpha;
    __device__ __forceinline__ void operator()(const pg8::f32x4 (&acc)[2][2][4][2], const pg8::Unit& u, int wr, int wc, int fr, int fq) const {
        const int row0 = u.pm * 256 + wr * 64 + fr, col0 = u.pn * 256 + wc * 32 + 4 * fq;
#pragma unroll
        for (int ai = 0; ai < 2; ++ai)
#pragma unroll
            for (int m = 0; m < 4; ++m) { const size_t off = (size_t)(row0 + ai * 128 + m * 16) * DM + col0;
#pragma unroll
                for (int bj = 0; bj < 2; ++bj)
#pragma unroll
                    for (int n = 0; n < 2; ++n) { const size_t o = off + bj * 128 + n * 16; const pg8::f32x4 xv = *(const pg8::f32x4*)(X + o);
                        *(pg8::f32x4*)(T + o) = xv * alpha + acc[ai][bj][m][n]; } }
    }
};

template <int ROWS, int COLS>
__device__ __forceinline__ void ld_tile(LAS bf16_t* dst, int ldl, const bf16_t* src, size_t ldg, int tid) {
    constexpr int CH = COLS / 8, TOT = ROWS * CH;
#pragma unroll
    for (int i0 = 0; i0 < TOT; i0 += 512) { const int i = i0 + tid; if (TOT % 512 == 0 || i < TOT) { const int r = i / CH, c = i % CH;
        const u32x4 v = *(const u32x4*)(src + (size_t)r * ldg + c * 8);
        *(LAS u32x4*)(dst + r * ldl + c * 8) = v; } }
}
template <int ROWS, int COLS>
__device__ __forceinline__ void ld_tile_T(LAS bf16_t* dst, int ldl, const bf16_t* src, size_t ldg, int tid) {
    constexpr int CH = COLS / 8, TOT = ROWS * CH;
#pragma unroll
    for (int i0 = 0; i0 < TOT; i0 += 512) { const int i = i0 + tid; const int r = i % ROWS, c = i / ROWS;
        const u32x4 v = *(const u32x4*)(src + (size_t)r * ldg + c * 8);
        LAS bf16_t* d = dst + (c * 8) * ldl + r;
        d[0] = (bf16_t)(v.x & 0xffffu); d[ldl] = (bf16_t)(v.x >> 16); d[2 * ldl] = (bf16_t)(v.y & 0xffffu); d[3 * ldl] = (bf16_t)(v.y >> 16);
        d[4 * ldl] = (bf16_t)(v.z & 0xffffu); d[5 * ldl] = (bf16_t)(v.z >> 16); d[6 * ldl] = (bf16_t)(v.w & 0xffffu); d[7 * ldl] = (bf16_t)(v.w >> 16); }
}
template <int NT, int KS>
__device__ __forceinline__ void mma_slab(f32x4 (&acc)[NT], const LAS bf16_t* A, int lda, const LAS bf16_t* Bt, int ldb, int lane) {
    const int r = lane & 15, q = lane >> 4;
    const LAS bf16_t* ap = A + r * lda + q * 8; const LAS bf16_t* bp = Bt + r * ldb + q * 8;
#pragma unroll
    for (int ks = 0; ks < KS; ++ks) { const bf16x8 a = *(const LAS bf16x8*)(ap + ks * 32);
#pragma unroll
        for (int t = 0; t < NT; ++t) { const bf16x8 b = *(const LAS bf16x8*)(bp + t * 16 * ldb + ks * 32);
            acc[t] = __builtin_amdgcn_mfma_f32_16x16x32_bf16(b, a, acc[t], 0, 0, 0); } }
}
template <int NT, int KS>
__device__ __forceinline__ void mma_slab_ra(f32x4 (&acc)[NT], const bf16x8 (&af)[KS], const LAS bf16_t* Bt, int ldb, int lane) {
    const int r = lane & 15, q = lane >> 4; const LAS bf16_t* bp = Bt + r * ldb + q * 8;
#pragma unroll
    for (int ks = 0; ks < KS; ++ks)
#pragma unroll
        for (int t = 0; t < NT; ++t) { const bf16x8 b = *(const LAS bf16x8*)(bp + t * 16 * ldb + ks * 32);
            acc[t] = __builtin_amdgcn_mfma_f32_16x16x32_bf16(b, af[ks], acc[t], 0, 0, 0); }
}
template <int NT, int KS>
__device__ __forceinline__ void mma_slab_n(f32x4 (&acc)[NT], const LAS bf16_t* A, int lda, const LAS bf16_t* Bt, int ldb, int lane) {
    const int r = lane & 15, q = lane >> 4;
    const LAS bf16_t* ap = A + r * lda + q * 8; const LAS bf16_t* bp = Bt + r * ldb + q * 8;
#pragma unroll
    for (int ks = 0; ks < KS; ++ks) { const bf16x8 a = *(const LAS bf16x8*)(ap + ks * 32);
#pragma unroll
        for (int t = 0; t < NT; ++t) { const bf16x8 b = *(const LAS bf16x8*)(bp + t * 16 * ldb + ks * 32);
            acc[t] = __builtin_amdgcn_mfma_f32_16x16x32_bf16(a, b, acc[t], 0, 0, 0); } }
}
template <int NT> __device__ __forceinline__ void zero_acc(f32x4 (&acc)[NT]) {
#pragma unroll
    for (int t = 0; t < NT; ++t) acc[t] = (f32x4){0.f, 0.f, 0.f, 0.f};
}
__device__ __forceinline__ void rope_sc(int pos, int k, float inv_half_log2theta, float& s, float& c) {
    const float fr = exp2f(-(float)k * inv_half_log2theta);
    const float ang = (float)pos * fr;
    const float n = rintf(ang * 0.15915494309189535f);
    float r = fmaf(-n, 6.28125f, ang); r = fmaf(-n, 1.9353071795864769e-3f, r);
    s = sinf(r); c = cosf(r);
}
constexpr float LOG2_THETA = 13.287712379549449f;
template <int HALF>
__device__ __forceinline__ void rope_lds(LAS bf16_t* T, int ld, int c0, const int* pos, float scale, int tid) {
    for (int i = tid; i < 128 * HALF; i += 512) { const int tok = i / HALF, k = i % HALF; float s, c; rope_sc(pos[tok], k, LOG2_THETA / HALF, s, c);
        LAS bf16_t* p = T + tok * ld + c0 + k; const float x1 = bf2f(p[0]), x2 = bf2f(p[HALF]);
        p[0] = f2bf((x1 * c - x2 * s) * scale); p[HALF] = f2bf((x2 * c + x1 * s) * scale); }
}
__device__ __forceinline__ float ret_log2g(int h) { return log2f(1.0f - exp2f(-5.0f - (float)h)); }
__device__ __forceinline__ float logsig(float f) { return fminf(f, 0.f) - log1pf(expf(-fabsf(f))); }

__device__ __forceinline__ void head_norm(f32x4 (&o)[8]) {
    float s = 0.f;
#pragma unroll
    for (int t = 0; t < 8; ++t) s += (o[t][0] + o[t][1]) + (o[t][2] + o[t][3]);
    const float mean = rsum4(s) * (1.0f / 128.0f); float q = 0.f;
#pragma unroll
    for (int t = 0; t < 8; ++t) { o[t] = o[t] - mean; q += (o[t][0] * o[t][0] + o[t][1] * o[t][1]) + (o[t][2] * o[t][2] + o[t][3] * o[t][3]); }
    const float rstd = rsqrtf(rsum4(q) * (1.0f / 128.0f) + 1e-5f);
#pragma unroll
    for (int t = 0; t < 8; ++t) o[t] = o[t] * rstd;
}

__device__ __forceinline__ int win_colmap(int n) {
    if (n < 2048) return n;
    if (n < 3584) return n + 64;
    if (n < 6144) return n + 72;
    if (n < 6208) return n - 6144 + 2048;
    if (n < 6216) return n - 6208 + 3648;
    return -1;
}
template <bool MAP>
__device__ __forceinline__ void conv_T(const float* src, int ldsrc, bf16_t* dst, int N, int K, const float* rowscale, LAS float* tile, int tid, int bid, int nb) {
    const int ntn = N / 64, ntiles = ntn * (K / 64);
    for (int ti = bid; ti < ntiles; ti += nb) { const int nt = ti % ntn, kt = ti / ntn;
        __syncthreads();
#pragma unroll
        for (int i = 0; i < 8; ++i) { const int r = (tid >> 6) + 8 * i, cc = tid & 63; const int n = nt * 64 + cc; const int oc = MAP ? win_colmap(n) : n;
            float v = oc >= 0 ? src[(size_t)(kt * 64 + r) * ldsrc + oc] : 0.f; if (rowscale) v *= rowscale[kt * 64 + r];
            tile[r * 65 + cc] = v; }
        __syncthreads();
#pragma unroll
        for (int i = 0; i < 8; ++i) { const int cc = (tid >> 6) + 8 * i, r = tid & 63;
            dst[(size_t)(nt * 64 + cc) * K + kt * 64 + r] = f2bf(tile[r * 65 + cc]); }
    }
}
__device__ __forceinline__ void cvt_flat(const float* src, bf16_t* dst, size_t n, int tid, int bid, int nb) {
    for (size_t i = ((size_t)bid * 512 + tid) * 8; i < n; i += (size_t)nb * 512 * 8) {
        const f32x4 a = *(const f32x4*)(src + i), b = *(const f32x4*)(src + i + 4);
        u32x4 w; w.x = pk2(a[0], a[1]); w.y = pk2(a[2], a[3]); w.z = pk2(b[0], b[1]); w.w = pk2(b[2], b[3]);
        *(u32x4*)(dst + i) = w; }
}
__device__ void phase0(const Prm& p, LAS unsigned char* lds, int tid, int bid, int nb) {
    asm volatile("" : "+v"(tid)); unsigned char* wsl = p.ws; asm volatile("" : "+s"(wsl));
    LAS float* tile = (LAS float*)lds;
    unsigned char* ws = wsl;
    for (int l = 0; l < DEPTH; ++l) {
        conv_T<true>(p.w_in + (size_t)l * DM * 6216, 6216, (bf16_t*)(ws + WS_WIN) + (size_t)l * NIN * DM, NIN, DM, nullptr, tile, tid, bid, nb);
        conv_T<false>(p.w_out + (size_t)l * DM * DM, DM, (bf16_t*)(ws + WS_WOUT) + (size_t)l * DM * DM, DM, DM, nullptr, tile, tid, bid, nb);
        conv_T<false>(p.w_mem_kv + (size_t)l * DM * 1024, 1024, (bf16_t*)(ws + WS_WMEM) + (size_t)l * 1024 * DM, 1024, DM, nullptr, tile, tid, bid, nb);
        conv_T<false>(p.mla_w_uq + (size_t)l * 384 * 768, 768, (bf16_t*)(ws + WS_WUQ) + (size_t)l * 768 * 384, 768, 384, p.mla_q_norm_g + l * 384, tile, tid, bid, nb);
        conv_T<false>(p.mla_w_ukv + (size_t)l * 128 * 1024, 1024, (bf16_t*)(ws + WS_WUKV) + (size_t)l * 1024 * 128, 1024, 128, p.mla_kv_norm_g + l * 128, tile, tid, bid, nb);
        for (int h = 0; h < 4; ++h) {
            conv_T<false>(p.ml_w_q + (size_t)(l * 4 + h) * 16384, 128, (bf16_t*)(ws + WS_WQ) + (size_t)(l * 4 + h) * 16384, 128, 128, nullptr, tile, tid, (bid + 8 * h + 32 * l) % nb, nb);
            conv_T<false>(p.ml_w_k + (size_t)(l * 4 + h) * 16384, 128, (bf16_t*)(ws + WS_WK) + (size_t)(l * 4 + h) * 16384, 128, 128, nullptr, tile, tid, (bid + 8 * h + 32 * l + 4) % nb, nb);
        }
    }
    cvt_flat(p.x, (bf16_t*)(ws + WS_XN), (size_t)NTOK * DM, tid, bid, nb);
    cvt_flat(p.mem, (bf16_t*)(ws + WS_MEMB), (size_t)2048 * DM, tid, bid, nb);
}

__device__ void ret_state(const Prm& p, LAS unsigned char* lds, int idx, int tid) {
    asm volatile("" : "+v"(tid)); unsigned char* wsl = p.ws; asm volatile("" : "+s"(wsl));
    const int c = idx & 15, h = (idx >> 4) & 3, b = idx >> 6, lane = tid & 63, w = tid >> 6;
    const size_t row0 = (size_t)b * SEQ + c * 128;
    const bf16_t* H = (const bf16_t*)(wsl + WS_H);
    LAS bf16_t* Ks = (LAS bf16_t*)lds; LAS bf16_t* KT = (LAS bf16_t*)(lds + REG); LAS bf16_t* VT = (LAS bf16_t*)(lds + 2 * REG);
    __syncthreads();
    ld_tile<128, 128>(Ks, TS, H + row0 * HLD + C_RK + h * 128, HLD, tid);
    ld_tile_T<128, 128>(VT, TS, H + row0 * HLD + C_RV + h * 128, HLD, tid);
    __syncthreads();
    const float lg2 = ret_log2g(h); const int* pos = p.pos + row0;
    for (int i = tid; i < 128 * 64; i += 512) { const int tok = i & 127, k = i >> 7; float s, cs; rope_sc(pos[tok], k, LOG2_THETA / 64.f, s, cs);
        const float x1 = bf2f(Ks[tok * TS + k]), x2 = bf2f(Ks[tok * TS + k + 64]);
        const float dk = exp2f(lg2 * (float)(127 - tok)) * 0.08838834764831845f;
        KT[k * TS + tok] = f2bf((x1 * cs - x2 * s) * dk); KT[(k + 64) * TS + tok] = f2bf((x2 * cs + x1 * s) * dk); }
    __syncthreads();
    f32x4 acc[8]; zero_acc(acc);
    mma_slab<8, 4>(acc, VT + (w * 16) * TS, TS, KT, TS, lane);
    bf16_t* U = (bf16_t*)(wsl + WS_URT) + (size_t)idx * 16384 + (w * 16 + (lane & 15)) * 128 + (lane >> 4) * 4;
#pragma unroll
    for (int t = 0; t < 8; ++t) { u32x2 v; v.x = pk2(acc[t][0], acc[t][1]); v.y = pk2(acc[t][2], acc[t][3]); *(u32x2*)(U + t * 16) = v; }
}

__device__ void mlstm_state(const Prm& p, LAS unsigned char* lds, int l, int idx, int tid) {
    asm volatile("" : "+v"(tid)); unsigned char* wsl = p.ws; asm volatile("" : "+s"(wsl));
    const int c = idx & 15, h = (idx >> 4) & 3, b = idx >> 6, lane = tid & 63, w = tid >> 6;
    const size_t row0 = (size_t)b * SEQ + c * 128;
    const bf16_t* H = (const bf16_t*)(wsl + WS_H); const float* HS = (const float*)(wsl + WS_HS);
    LAS bf16_t* XCs = (LAS bf16_t*)lds; LAS bf16_t* W = (LAS bf16_t*)(lds + REG); LAS bf16_t* VT = (LAS bf16_t*)(lds + 2 * REG); LAS bf16_t* KT = (LAS bf16_t*)(lds + 3 * REG);
    LAS float* lf = (LAS float*)(lds + MISC_OFF); LAS float* al = lf + 128; LAS float* wk = lf + 256;
    __syncthreads();
    if (tid < 128) lf[tid] = logsig(HS[(row0 + tid) * 256 + S_LF + h] + p.ml_f_bias[l * 4 + h]);
    for (int i = tid; i < 128 * 16; i += 512) { const int tok = i >> 4, ch8 = (i & 15) * 8; const int chg = h * 128 + ch8;
        float a[8];
        { const f32x4 b0 = *(const f32x4*)(p.ml_conv_b + l * 512 + chg), b1 = *(const f32x4*)(p.ml_conv_b + l * 512 + chg + 4);
          a[0] = b0[0]; a[1] = b0[1]; a[2] = b0[2]; a[3] = b0[3]; a[4] = b1[0]; a[5] = b1[1]; a[6] = b1[2]; a[7] = b1[3]; }
#pragma unroll
        for (int jj = 0; jj < 4; ++jj) { const int t = c * 128 + tok - 3 + jj;
            if (t >= 0) { const u32x4 xv = *(const u32x4*)(H + ((size_t)b * SEQ + t) * HLD + C_LX + chg);
                const float* wp = p.ml_conv_w + ((size_t)l * 4 + jj) * 512 + chg; const f32x4 w0 = *(const f32x4*)wp, w1 = *(const f32x4*)(wp + 4);
                a[0] += w0[0] * lo16(xv.x); a[1] += w0[1] * hi16(xv.x); a[2] += w0[2] * lo16(xv.y); a[3] += w0[3] * hi16(xv.y);
                a[4] += w1[0] * lo16(xv.z); a[5] += w1[1] * hi16(xv.z); a[6] += w1[2] * lo16(xv.w); a[7] += w1[3] * hi16(xv.w); } }
        u32x4 o; o.x = pk2(siluf(a[0]), siluf(a[1])); o.y = pk2(siluf(a[2]), siluf(a[3])); o.z = pk2(siluf(a[4]), siluf(a[5])); o.w = pk2(siluf(a[6]), siluf(a[7]));
        *(LAS u32x4*)(XCs + tok * TS + ch8) = o;
        *(u32x4*)((bf16_t*)(wsl + WS_XC) + (row0 + tok) * 512 + chg) = o; }
    ld_tile<128, 128>(W, TS, (const bf16_t*)(wsl + WS_WQ) + (size_t)(l * 4 + h) * 16384, 128, tid);
    ld_tile_T<128, 128>(VT, TS, H + row0 * HLD + C_LV + h * 128, HLD, tid);
    __syncthreads();
    float cum = 0.f;
    if (tid < 128) { for (int r = 0; r <= tid; ++r) cum += lf[r];
        al[tid] = HS[(row0 + tid) * 256 + S_LI + h] + p.ml_i_bias[l * 4 + h] - cum; }
    __syncthreads();
    float mloc = -3.0e38f;
    for (int r = 0; r < 128; ++r) mloc = fmaxf(mloc, al[r]);
    if (tid < 128) wk[tid] = expf(al[tid] - mloc);
    if (tid == 127) { float* g = (float*)(wsl + WS_GSC) + idx * 2; g[0] = cum; g[1] = mloc; }
    const int tok = w * 16 + (lane & 15), q4 = (lane >> 4) * 4;
    const size_t hb = ((size_t)(b * 4 + h) * SEQ + c * 128 + tok) * 128 + q4;
    {   f32x4 acc[8]; zero_acc(acc);
        mma_slab<8, 4>(acc, XCs + (w * 16) * TS, TS, W, TS, lane);
        bf16_t* o = (bf16_t*)(wsl + WS_LQ) + hb;
#pragma unroll
        for (int t = 0; t < 8; ++t) { u32x2 v; v.x = pk2(acc[t][0], acc[t][1]); v.y = pk2(acc[t][2], acc[t][3]); *(u32x2*)(o + t * 16) = v; } }
    __syncthreads();
    ld_tile<128, 128>(W, TS, (const bf16_t*)(wsl + WS_WK) + (size_t)(l * 4 + h) * 16384, 128, tid);
    __syncthreads();
    {   f32x4 acc[8]; zero_acc(acc);
        mma_slab<8, 4>(acc, XCs + (w * 16) * TS, TS, W, TS, lane);
        bf16_t* o = (bf16_t*)(wsl + WS_LK) + hb; const float wt = wk[tok];
#pragma unroll
        for (int t = 0; t < 8; ++t) { acc[t] = acc[t] * 0.08838834764831845f;
            u32x2 v; v.x = pk2(acc[t][0], acc[t][1]); v.y = pk2(acc[t][2], acc[t][3]); *(u32x2*)(o + t * 16) = v;
#pragma unroll
            for (int j = 0; j < 4; ++j) KT[(t * 16 + q4 + j) * TS + tok] = f2bf(acc[t][j] * wt); } }
    __syncthreads();
    if (tid < 128) { float s = 0.f; for (int r = 0; r < 128; ++r) s += bf2f(KT[tid * TS + r]); ((float*)(wsl + WS_NV))[idx * 128 + tid] = s; }
    {   f32x4 acc[8]; zero_acc(acc);
        mma_slab<8, 4>(acc, VT + (w * 16) * TS, TS, KT, TS, lane);
        bf16_t* U = (bf16_t*)(wsl + WS_ULT) + (size_t)idx * 16384 + (w * 16 + (lane & 15)) * 128 + q4;
#pragma unroll
        for (int t = 0; t < 8; ++t) { u32x2 v; v.x = pk2(acc[t][0], acc[t][1]); v.y = pk2(acc[t][2], acc[t][3]); *(u32x2*)(U + t * 16) = v; } }
}

__device__ void mla_proj(const Prm& p, LAS unsigned char* lds, int l, int idx, int tid) {
    asm volatile("" : "+v"(tid)); unsigned char* wsl = p.ws; asm volatile("" : "+s"(wsl));
    const int h = idx & 3, tt = idx >> 2, b = tt >> 4, t0 = (tt & 15) * 128, lane = tid & 63, w = tid >> 6;
    const size_t row0 = (size_t)tt * 128;
    const bf16_t* H = (const bf16_t*)(wsl + WS_H); const float* HS = (const float*)(wsl + WS_HS);
    LAS bf16_t* As = (LAS bf16_t*)lds; LAS bf16_t* Bs = (LAS bf16_t*)(lds + REG);
    LAS float* rsq = (LAS float*)(lds + MISC_OFF); LAS float* rskv = rsq + 128;
    __syncthreads();
    {   const int r = tid >> 2, part = tid & 3; const bf16_t* rp = H + (row0 + r) * HLD; float ss = 0.f, s2 = 0.f;
#pragma unroll
        for (int i = 0; i < 12; ++i) { const u32x4 v = *(const u32x4*)(rp + C_ACQ + part * 96 + i * 8);
            ss += lo16(v.x) * lo16(v.x) + hi16(v.x) * hi16(v.x) + lo16(v.y) * lo16(v.y) + hi16(v.y) * hi16(v.y) + lo16(v.z) * lo16(v.z) + hi16(v.z) * hi16(v.z) + lo16(v.w) * lo16(v.w) + hi16(v.w) * hi16(v.w); }
#pragma unroll
        for (int i = 0; i < 4; ++i) { const u32x4 v = *(const u32x4*)(rp + C_ACKV + part * 32 + i * 8);
            s2 += lo16(v.x) * lo16(v.x) + hi16(v.x) * hi16(v.x) + lo16(v.y) * lo16(v.y) + hi16(v.y) * hi16(v.y) + lo16(v.z) * lo16(v.z) + hi16(v.z) * hi16(v.z) + lo16(v.w) * lo16(v.w) + hi16(v.w) * hi16(v.w); }
        ss += __shfl_xor(ss, 1); ss += __shfl_xor(ss, 2); s2 += __shfl_xor(s2, 1); s2 += __shfl_xor(s2, 2);
        if (part == 0) { rsq[r] = rsqrtf(ss * (1.0f / 384.0f) + 1e-6f); rskv[r] = rsqrtf(s2 * (1.0f / 128.0f) + 1e-6f); } }
    const int tok = w * 16 + (lane & 15), q4 = (lane >> 4) * 4;
    const size_t hrow = (size_t)(b * 4 + h) * SEQ + t0 + tok;
    {   f32x4 acc[12]; zero_acc(acc);
        for (int kc = 0; kc < 3; ++kc) {
            __syncthreads();
            ld_tile<128, 128>(As, TS, H + row0 * HLD + C_ACQ + kc * 128, HLD, tid);
            ld_tile<192, 128>(Bs, TS, (const bf16_t*)(wsl + WS_WUQ) + ((size_t)l * 768 + h * 192) * 384 + kc * 128, 384, tid);
            __syncthreads();
            mma_slab<12, 4>(acc, As + (w * 16) * TS, TS, Bs, TS, lane);
        }
        const float rs = rsq[tok] * 0.07216878364870322f;
        bf16_t* o = (bf16_t*)(wsl + WS_QA) + hrow * 192 + q4;
#pragma unroll
        for (int t = 0; t < 8; ++t) { u32x2 v; v.x = pk2(acc[t][0] * rs, acc[t][1] * rs); v.y = pk2(acc[t][2] * rs, acc[t][3] * rs); *(u32x2*)(o + t * 16) = v; }
        const int pos = p.pos[b * SEQ + t0 + tok];
#pragma unroll
        for (int t2 = 0; t2 < 2; ++t2) { float o1[4], o2[4];
#pragma unroll
            for (int j = 0; j < 4; ++j) { float s, cs; rope_sc(pos, t2 * 16 + q4 + j, LOG2_THETA / 32.f, s, cs); const float x1 = acc[8 + t2][j] * rs, x2 = acc[10 + t2][j] * rs;
                o1[j] = x1 * cs - x2 * s; o2[j] = x2 * cs + x1 * s; }
            u32x2 v; v.x = pk2(o1[0], o1[1]); v.y = pk2(o1[2], o1[3]); *(u32x2*)(o + 128 + t2 * 16) = v;
            v.x = pk2(o2[0], o2[1]); v.y = pk2(o2[2], o2[3]); *(u32x2*)(o + 160 + t2 * 16) = v; } }
    __syncthreads();
    ld_tile<128, 128>(As, TS, H + row0 * HLD + C_ACKV, HLD, tid);
    ld_tile<256, 128>(Bs, TS, (const bf16_t*)(wsl + WS_WUKV) + ((size_t)l * 1024 + h * 256) * 128, 128, tid);
    __syncthreads();
    {   f32x4 acc[8]; zero_acc(acc);
        mma_slab<8, 4>(acc, As + (w * 16) * TS, TS, Bs, TS, lane);
        const float rs = rskv[tok]; bf16_t* o = (bf16_t*)(wsl + WS_KA) + hrow * 192 + q4;
#pragma unroll
        for (int t = 0; t < 8; ++t) { u32x2 v; v.x = pk2(acc[t][0] * rs, acc[t][1] * rs); v.y = pk2(acc[t][2] * rs, acc[t][3] * rs); *(u32x2*)(o + t * 16) = v; } }
    {   f32x4 acc[8]; zero_acc(acc);
        mma_slab_n<8, 4>(acc, As + (w * 16) * TS, TS, Bs + 128 * TS, TS, lane);
        const int tk = w * 16 + q4; const float r0 = rskv[tk], r1 = rskv[tk + 1], r2 = rskv[tk + 2], r3 = rskv[tk + 3];
        bf16_t* o = (bf16_t*)(wsl + WS_VAT) + ((size_t)(b * 4 + h) * 128 + (lane & 15)) * SEQ + t0 + tk;
#pragma unroll
        for (int t = 0; t < 8; ++t) { u32x2 v; v.x = pk2(acc[t][0] * r0, acc[t][1] * r1); v.y = pk2(acc[t][2] * r2, acc[t][3] * r3); *(u32x2*)(o + (size_t)t * 16 * SEQ) = v; } }
    for (int i = tid; i < 128 * 32; i += 512) { const int tk = i >> 5, k = i & 31; float s, cs; rope_sc(p.pos[b * SEQ + t0 + tk], k, LOG2_THETA / 32.f, s, cs);
        const float* src = HS + (row0 + tk) * 256 + S_KPE; const float x1 = src[k], x2 = src[k + 32];
        bf16_t* o = (bf16_t*)(wsl + WS_KA) + ((size_t)(b * 4 + h) * SEQ + t0 + tk) * 192 + 128;
        o[k] = f2bf(x1 * cs - x2 * s); o[k + 32] = f2bf(x2 * cs + x1 * s); }
}

template <int DK, bool CAUSAL, bool VT_GLOBAL>
__device__ void attn_item(const Prm& p, LAS unsigned char* lds, const bf16_t* Q, size_t ldq, const bf16_t* K, size_t ldk, const bf16_t* V, size_t ldv,
                          int nkb, float sscale, size_t yrow0, int ycol, int tid) {
    asm volatile("" : "+v"(tid)); unsigned char* wsl = p.ws; asm volatile("" : "+s"(wsl));
    constexpr int KS = DK / 32, LQ = DK + 8;
    const int lane = tid & 63, w = tid >> 6;
    LAS bf16_t* Qs = (LAS bf16_t*)lds; LAS bf16_t* Ks = (LAS bf16_t*)(lds + 51200); LAS bf16_t* VT = (LAS bf16_t*)(lds + 102400);
    __syncthreads();
    ld_tile<128, DK>(Qs, LQ, Q, ldq, tid);
    __syncthreads();
    bf16x8 qf[KS];
#pragma unroll
    for (int ks = 0; ks < KS; ++ks) qf[ks] = *(const LAS bf16x8*)(Qs + (w * 16 + (lane & 15)) * LQ + ks * 32 + (lane >> 4) * 8);
    f32x4 O[8]; zero_acc(O);
    float m_run = -3.0e38f, l_run = 0.f;
    const int ql = w * 16 + (lane & 15), q4 = (lane >> 4) * 4;
    for (int kb = 0; kb < nkb; ++kb) {
        __syncthreads();
        ld_tile<128, DK>(Ks, LQ, K + (size_t)kb * 128 * ldk, ldk, tid);
        if (VT_GLOBAL) ld_tile<128, 128>(VT, TS, V + (size_t)kb * 128, ldv, tid);
        else ld_tile_T<128, 128>(VT, TS, V + (size_t)kb * 128 * ldv, ldv, tid);
        __syncthreads();
        f32x4 S[8]; zero_acc(S);
        mma_slab_ra<8, KS>(S, qf, Ks, LQ, lane);
        float mx = -3.0e38f;
#pragma unroll
        for (int t = 0; t < 8; ++t)
#pragma unroll
            for (int j = 0; j < 4; ++j) { float s = S[t][j] * sscale; if (CAUSAL && kb == nkb - 1 && (t * 16 + q4 + j) > ql) s = -3.0e38f; S[t][j] = s; mx = fmaxf(mx, s); }
        mx = rmax4(mx);
        const float m_new = fmaxf(m_run, mx), alpha = __expf(m_run - m_new);
        float rs = 0.f;
#pragma unroll
        for (int t = 0; t < 8; ++t) {
#pragma unroll
            for (int j = 0; j < 4; ++j) { const float e = __expf(S[t][j] - m_new); S[t][j] = e; rs += e; }
            u32x2 v; v.x = pk2(S[t][0], S[t][1]); v.y = pk2(S[t][2], S[t][3]);
            *(LAS u32x2*)(Qs + ql * TS + t * 16 + q4) = v; O[t] = O[t] * alpha; }
        l_run = l_run * alpha + rsum4(rs); m_run = m_new;
        __syncthreads();
        mma_slab<8, 4>(O, Qs + (w * 16) * TS, TS, VT, TS, lane);
    }
    const float inv = 1.0f / l_run;
    const bf16_t* zp = (const bf16_t*)(wsl + WS_H) + (yrow0 + ql) * HLD + C_Z + ycol + q4;
    bf16_t* yp = (bf16_t*)(wsl + WS_Y) + (yrow0 + ql) * DM + ycol + q4;
#pragma unroll
    for (int t = 0; t < 8; ++t) { const u32x2 z = *(const u32x2*)(zp + t * 16);
        u32x2 v; v.x = pk2(O[t][0] * inv * siluf(lo16(z.x)), O[t][1] * inv * siluf(hi16(z.x))); v.y = pk2(O[t][2] * inv * siluf(lo16(z.y)), O[t][3] * inv * siluf(hi16(z.y)));
        *(u32x2*)(yp + t * 16) = v; }
}

__device__ void ret_out(const Prm& p, LAS unsigned char* lds, int l, int idx, int tid) {
    asm volatile("" : "+v"(tid)); unsigned char* wsl = p.ws; asm volatile("" : "+s"(wsl));
    const int c = idx & 15, h = (idx >> 4) & 3, b = idx >> 6, lane = tid & 63, w = tid >> 6;
    const size_t row0 = (size_t)b * SEQ + c * 128;
    const bf16_t* H = (const bf16_t*)(wsl + WS_H);
    LAS bf16_t* Qs = (LAS bf16_t*)lds; LAS bf16_t* Ks = (LAS bf16_t*)(lds + REG); LAS bf16_t* VT = (LAS bf16_t*)(lds + 2 * REG); LAS bf16_t* ST = (LAS bf16_t*)(lds + 3 * REG);
    const float lg2 = ret_log2g(h);
    __syncthreads();
    ld_tile<128, 128>(Qs, TS, H + row0 * HLD + C_RQ + h * 128, HLD, tid);
    ld_tile<128, 128>(Ks, TS, H + row0 * HLD + C_RK + h * 128, HLD, tid);
    ld_tile_T<128, 128>(VT, TS, H + row0 * HLD + C_RV + h * 128, HLD, tid);
    {   float a[4][8];
#pragma unroll
        for (int i = 0; i < 4; ++i)
#pragma unroll
            for (int e = 0; e < 8; ++e) a[i][e] = 0.f;
        const bf16_t* U0 = (const bf16_t*)(wsl + WS_URT) + (size_t)(idx - c) * 16384;
        for (int j = 0; j < c; ++j) { const float wj = exp2f(lg2 * 128.f * (float)(c - 1 - j));
#pragma unroll
            for (int i = 0; i < 4; ++i) { const u32x4 v = *(const u32x4*)(U0 + (size_t)j * 16384 + (tid + 512 * i) * 8);
                a[i][0] += wj * lo16(v.x); a[i][1] += wj * hi16(v.x); a[i][2] += wj * lo16(v.y); a[i][3] += wj * hi16(v.y);
                a[i][4] += wj * lo16(v.z); a[i][5] += wj * hi16(v.z); a[i][6] += wj * lo16(v.w); a[i][7] += wj * hi16(v.w); } }
#pragma unroll
        for (int i = 0; i < 4; ++i) { const int off = (tid + 512 * i) * 8, dv = off >> 7, dk = off & 127;
            u32x4 o; o.x = pk2(a[i][0], a[i][1]); o.y = pk2(a[i][2], a[i][3]); o.z = pk2(a[i][4], a[i][5]); o.w = pk2(a[i][6], a[i][7]);
            *(LAS u32x4*)(ST + dv * TS + dk) = o; } }
    __syncthreads();
    rope_lds<64>(Qs, TS, 0, p.pos + row0, 1.0f, tid);
    rope_lds<64>(Ks, TS, 0, p.pos + row0, 0.08838834764831845f, tid);
    __syncthreads();
    const int ql = w * 16 + (lane & 15), q4 = (lane >> 4) * 4;
    f32x4 S[8]; zero_acc(S);
    mma_slab<8, 4>(S, Qs + (w * 16) * TS, TS, Ks, TS, lane);
    __syncthreads();
#pragma unroll
    for (int t = 0; t < 8; ++t) {
#pragma unroll
        for (int j = 0; j < 4; ++j) { const int rel = ql - (t * 16 + q4 + j); S[t][j] = rel >= 0 ? S[t][j] * exp2f(lg2 * (float)rel) : 0.f; }
        u32x2 v; v.x = pk2(S[t][0], S[t][1]); v.y = pk2(S[t][2], S[t][3]); *(LAS u32x2*)(Ks + ql * TS + t * 16 + q4) = v; }
    __syncthreads();
    f32x4 O[8]; zero_acc(O);
    mma_slab<8, 4>(O, Ks + (w * 16) * TS, TS, VT, TS, lane);
    f32x4 O2[8]; zero_acc(O2);
    mma_slab<8, 4>(O2, Qs + (w * 16) * TS, TS, ST, TS, lane);
    const float dq = exp2f(lg2 * (float)(ql + 1));
#pragma unroll
    for (int t = 0; t < 8; ++t) O[t] = O[t] + O2[t] * dq;
    head_norm(O);
    const float* g = p.ret_norm_g + l * 512 + h * 128 + q4;
    const bf16_t* zp = H + (row0 + ql) * HLD + C_Z + h * 128 + q4;
    bf16_t* yp = (bf16_t*)(wsl + WS_Y) + (row0 + ql) * DM + h * 128 + q4;
#pragma unroll
    for (int t = 0; t < 8; ++t) { const u32x2 z = *(const u32x2*)(zp + t * 16); const f32x4 gv = *(const f32x4*)(g + t * 16);
        u32x2 v; v.x = pk2(O[t][0] * gv[0] * siluf(lo16(z.x)), O[t][1] * gv[1] * siluf(hi16(z.x))); v.y = pk2(O[t][2] * gv[2] * siluf(lo16(z.y)), O[t][3] * gv[3] * siluf(hi16(z.y)));
        *(u32x2*)(yp + t * 16) = v; }
}

__device__ void mlstm_out(const Prm& p, LAS unsigned char* lds, int l, int idx, int tid) {
    asm volatile("" : "+v"(tid)); unsigned char* wsl = p.ws; asm volatile("" : "+s"(wsl));
    const int c = idx & 15, h = (idx >> 4) & 3, b = idx >> 6, lane = tid & 63, w = tid >> 6;
    const size_t row0 = (size_t)b * SEQ + c * 128;
    const bf16_t* H = (const bf16_t*)(wsl + WS_H); const float* HS = (const float*)(wsl + WS_HS);
    LAS bf16_t* Qs = (LAS bf16_t*)lds; LAS bf16_t* Ks = (LAS bf16_t*)(lds + REG); LAS bf16_t* VT = (LAS bf16_t*)(lds + 2 * REG); LAS bf16_t* ST = (LAS bf16_t*)(lds + 3 * REG);
    LAS float* lf = (LAS float*)(lds + MISC_OFF); LAS float* ag = lf + 128; LAS float* Mx = lf + 256; LAS float* wint = lf + 384; LAS float* em = lf + 512; LAS float* nst = lf + 640;
    const float* gsc = (const float*)(wsl + WS_GSC) + (size_t)(idx - c) * 2;
    float G = 0.f, Mref = 0.f;
    for (int j = 0; j < c; ++j) { Mref = fmaxf(Mref, gsc[2 * j + 1] - G); G += gsc[2 * j]; }
    __syncthreads();
    if (tid < 128) lf[tid] = logsig(HS[(row0 + tid) * 256 + S_LF + h] + p.ml_f_bias[l * 4 + h]);
    const size_t hb0 = ((size_t)(b * 4 + h) * SEQ + c * 128) * 128;
    ld_tile<128, 128>(Qs, TS, (const bf16_t*)(wsl + WS_LQ) + hb0, 128, tid);
    ld_tile<128, 128>(Ks, TS, (const bf16_t*)(wsl + WS_LK) + hb0, 128, tid);
    ld_tile_T<128, 128>(VT, TS, H + row0 * HLD + C_LV + h * 128, HLD, tid);
    {   float a[4][8]; float nacc = 0.f;
#pragma unroll
        for (int i = 0; i < 4; ++i)
#pragma unroll
            for (int e = 0; e < 8; ++e) a[i][e] = 0.f;
        const bf16_t* U0 = (const bf16_t*)(wsl + WS_ULT) + (size_t)(idx - c) * 16384; const float* NV0 = (const float*)(wsl + WS_NV) + (size_t)(idx - c) * 128;
        float G2 = 0.f;
        for (int j = 0; j < c; ++j) { const float wj = expf(gsc[2 * j + 1] - G2 - Mref); G2 += gsc[2 * j];
            if (tid < 128) nacc += wj * NV0[j * 128 + tid];
#pragma unroll
            for (int i = 0; i < 4; ++i) { const u32x4 v = *(const u32x4*)(U0 + (size_t)j * 16384 + (tid + 512 * i) * 8);
                a[i][0] += wj * lo16(v.x); a[i][1] += wj * hi16(v.x); a[i][2] += wj * lo16(v.y); a[i][3] += wj * hi16(v.y);
                a[i][4] += wj * lo16(v.z); a[i][5] += wj * hi16(v.z); a[i][6] += wj * lo16(v.w); a[i][7] += wj * hi16(v.w); } }
        if (tid < 128) nst[tid] = nacc;
#pragma unroll
        for (int i = 0; i < 4; ++i) { const int off = (tid + 512 * i) * 8, dv = off >> 7, dk = off & 127;
            u32x4 o; o.x = pk2(a[i][0], a[i][1]); o.y = pk2(a[i][2], a[i][3]); o.z = pk2(a[i][4], a[i][5]); o.w = pk2(a[i][6], a[i][7]);
            *(LAS u32x4*)(ST + dv * TS + dk) = o; } }
    __syncthreads();
    float cum = 0.f;
    if (tid < 128) { for (int r = 0; r <= tid; ++r) cum += lf[r];
        ag[tid] = HS[(row0 + tid) * 256 + S_LI + h] + p.ml_i_bias[l * 4 + h] - cum - G; }
    __syncthreads();
    if (tid < 128) { float mx = Mref; for (int r = 0; r <= tid; ++r) mx = fmaxf(mx, ag[r]);
        Mx[tid] = mx; wint[tid] = expf(Mref - mx); em[tid] = expf(-(G + cum + mx)); }
    __syncthreads();
    const int ql = w * 16 + (lane & 15), q4 = (lane >> 4) * 4;
    f32x4 S[8]; zero_acc(S);
    mma_slab<8, 4>(S, Qs + (w * 16) * TS, TS, Ks, TS, lane);
    const float mq = Mx[ql]; float den = 0.f;
    __syncthreads();
#pragma unroll
    for (int t = 0; t < 8; ++t) {
#pragma unroll
        for (int j = 0; j < 4; ++j) { const int key = t * 16 + q4 + j; const float sv = key <= ql ? S[t][j] * expf(ag[key] - mq) : 0.f; S[t][j] = sv; den += sv; }
        u32x2 v; v.x = pk2(S[t][0], S[t][1]); v.y = pk2(S[t][2], S[t][3]); *(LAS u32x2*)(Ks + ql * TS + t * 16 + q4) = v; }
    den = rsum4(den);
    float qn = 0.f;
#pragma unroll
    for (int i = 0; i < 32; ++i) qn += bf2f(Qs[ql * TS + q4 * 8 + i]) * nst[q4 * 8 + i];
    qn = rsum4(qn);
    __syncthreads();
    f32x4 O[8]; zero_acc(O);
    mma_slab<8, 4>(O, Ks + (w * 16) * TS, TS, VT, TS, lane);
    f32x4 O2[8]; zero_acc(O2);
    mma_slab<8, 4>(O2, Qs + (w * 16) * TS, TS, ST, TS, lane);
    const float wi = wint[ql]; den += wi * qn;
    const float invd = 1.0f / fmaxf(fabsf(den), em[ql]);
    const bf16_t* lop = H + (row0 + ql) * HLD + C_LO + h * 128 + q4;
#pragma unroll
    for (int t = 0; t < 8; ++t) { const u32x2 lo = *(const u32x2*)(lop + t * 16);
        O[t] = (O[t] + O2[t] * wi) * invd;
        O[t][0] *= sigmf(lo16(lo.x)); O[t][1] *= sigmf(hi16(lo.x)); O[t][2] *= sigmf(lo16(lo.y)); O[t][3] *= sigmf(hi16(lo.y)); }
    head_norm(O);
    const float* g = p.ml_norm_g + l * 512 + h * 128 + q4; const float* sk = p.ml_skip + l * 512 + h * 128 + q4;
    const bf16_t* xcp = (const bf16_t*)(wsl + WS_XC) + (row0 + ql) * 512 + h * 128 + q4;
    const bf16_t* zp = H + (row0 + ql) * HLD + C_Z + 1024 + h * 128 + q4;
    bf16_t* yp = (bf16_t*)(wsl + WS_Y) + (row0 + ql) * DM + 1024 + h * 128 + q4;
#pragma unroll
    for (int t = 0; t < 8; ++t) { const u32x2 z = *(const u32x2*)(zp + t * 16), xc = *(const u32x2*)(xcp + t * 16); const f32x4 gv = *(const f32x4*)(g + t * 16), sv = *(const f32x4*)(sk + t * 16);
        const float y0 = (O[t][0] * gv[0] + sv[0] * lo16(xc.x)) * siluf(lo16(z.x)), y1 = (O[t][1] * gv[1] + sv[1] * hi16(xc.x)) * siluf(hi16(z.x));
        const float y2 = (O[t][2] * gv[2] + sv[2] * lo16(xc.y)) * siluf(lo16(z.y)), y3 = (O[t][3] * gv[3] + sv[3] * hi16(xc.y)) * siluf(hi16(z.y));
        u32x2 v; v.x = pk2(y0, y1); v.y = pk2(y2, y3); *(u32x2*)(yp + t * 16) = v; }
}

__device__ void ln_pass(const Prm& p, int l, int tid, int bid, int nb) {
    asm volatile("" : "+v"(tid)); unsigned char* wsl = p.ws; asm volatile("" : "+s"(wsl));
    const int lane = tid & 63, w = tid >> 6; float* T = p.out; bf16_t* XN = (bf16_t*)(wsl + WS_XN);
    const float* g = p.ln_g + l * DM; const float* bb = p.ln_b + l * DM;
    for (int row = bid * 8 + w; row < NTOK; row += nb * 8) { float* rp = T + (size_t)row * DM + lane * 4;
        f32x4 v[8]; float s = 0.f;
#pragma unroll
        for (int i = 0; i < 8; ++i) { v[i] = *(const f32x4*)(rp + i * 256); s += (v[i][0] + v[i][1]) + (v[i][2] + v[i][3]); }
#pragma unroll
        for (int o = 1; o < 64; o <<= 1) s += __shfl_xor(s, o);
        const float mean = s * (1.0f / DM); float q = 0.f;
#pragma unroll
        for (int i = 0; i < 8; ++i) { v[i] = v[i] - mean; q += (v[i][0] * v[i][0] + v[i][1] * v[i][1]) + (v[i][2] * v[i][2] + v[i][3] * v[i][3]); }
#pragma unroll
        for (int o = 1; o < 64; o <<= 1) q += __shfl_xor(q, o);
        const float rstd = rsqrtf(q * (1.0f / DM) + 1e-5f);
#pragma unroll
        for (int i = 0; i < 8; ++i) { const f32x4 gv = *(const f32x4*)(g + lane * 4 + i * 256), bv = *(const f32x4*)(bb + lane * 4 + i * 256);
            const f32x4 y = v[i] * rstd * gv + bv; *(f32x4*)(rp + i * 256) = y;
            u32x2 o; o.x = pk2(y[0], y[1]); o.y = pk2(y[2], y[3]); *(u32x2*)(XN + (size_t)row * DM + lane * 4 + i * 256) = o; } }
}

__device__ __forceinline__ int pair16(int k) { return k < 256 ? (k & 31) * 16 + (k >> 5) : (k & 31) * 16 + 15 - ((k - 256) >> 5); }

__global__ void __launch_bounds__(512, 2) fwd_kernel(Prm p) {
    extern __shared__ __attribute__((aligned(16))) unsigned char lds_raw[];
    LAS unsigned char* lds = (LAS unsigned char*)lds_raw;
    const int tid = threadIdx.x, bid = blockIdx.x, nb = gridDim.x;
    for (int ph = p.ph_lo; ph < p.ph_hi; ++ph) {
        unsigned char* ws = p.ws; asm volatile("" : "+s"(ws));
#ifndef NO_P0
        if (ph == 0) phase0(p, lds, tid, bid, nb);
#else
        if (ph == 0) {}
#endif
        else {
            const int l = (ph - 1) / 5, sub = (ph - 1) % 5;
            if (sub == 0) {
#ifndef NO_G1
                {   pg8::Gemm g{(const pg8::bf16_t*)(ws + WS_XN), (const pg8::bf16_t*)(ws + WS_WIN) + (size_t)l * NIN * DM, NTOK, NIN, DM};
                    pg8::StaticOrder S; S.init(NTOK, NIN, nb, bid);
                    EpiH E{(bf16_t*)(ws + WS_H), (float*)(ws + WS_HS)};
                    pg8::gemm_phase<EpiH, pg8::StaticOrder>(lds, g, S, E, nullptr); }
                {   pg8::Gemm g{(const pg8::bf16_t*)(ws + WS_MEMB), (const pg8::bf16_t*)(ws + WS_WMEM) + (size_t)l * 1024 * DM, 2048, 1024, DM};
                    pg8::StaticOrder S; S.init(2048, 1024, nb, (bid + nb - 64 % nb) % nb);
                    pg8::EpiBf16<0> E{(pg8::bf16_t*)(ws + WS_MKV), 1024, nullptr, 0, 0};
                    pg8::gemm_phase<pg8::EpiBf16<0>, pg8::StaticOrder>(lds, g, S, E, nullptr); }
#endif
            } else if (sub == 1) {
#ifndef NO_2A
                for (int i = bid; i < 2048; i += nb) { const int ty = i >> 9, k = i & 511;
#ifndef ONLY
#define ONLY -1
#endif
                    if (ty == 0) { if (ONLY < 0 || ONLY == 0) ret_state(p, lds, k, tid); }
                    else if (ty == 1) { if (ONLY < 0 || ONLY == 1) mlstm_state(p, lds, l, k, tid); }
                    else if (ty == 2) { if (ONLY < 0 || ONLY == 2) mla_proj(p, lds, l, k, tid); }
                    else if (ONLY < 0 || ONLY == 3) { const int h = k & 3, qb = (k >> 2) & 15, b = k >> 6; const bf16_t* MKV = (const bf16_t*)(ws + WS_MKV);
                        attn_item<128, false, false>(p, lds, (const bf16_t*)(ws + WS_H) + ((size_t)b * SEQ + qb * 128) * HLD + C_CQ + h * 128, HLD,
                            MKV + (size_t)b * 256 * 1024 + h * 128, 1024, MKV + (size_t)b * 256 * 1024 + 512 + h * 128, 1024, 2, 0.08838834764831845f, (size_t)b * SEQ + qb * 128, 1536 + h * 128, tid); } }
#endif
            } else if (sub == 2) {
#ifndef NO_2B
                for (int i = bid; i < 1536; i += nb) { const int ty = i >> 9, k = i & 511; const int idx = pair16(k);
                    if (ty == 0) { if (ONLY < 0 || ONLY == 4) ret_out(p, lds, l, idx, tid); }
                    else if (ty == 1) { if (ONLY < 0 || ONLY == 5) mlstm_out(p, lds, l, idx, tid); }
                    else if (ONLY < 0 || ONLY == 6) { const int qb = idx & 15, bh = idx >> 4, b = bh >> 2, h = bh & 3;
                        attn_item<192, true, true>(p, lds, (const bf16_t*)(ws + WS_QA) + ((size_t)bh * SEQ + qb * 128) * 192, 192, (const bf16_t*)(ws + WS_KA) + (size_t)bh * SEQ * 192, 192,
                            (const bf16_t*)(ws + WS_VAT) + (size_t)bh * 128 * SEQ, SEQ, qb + 1, 1.0f, (size_t)b * SEQ + qb * 128, 512 + h * 128, tid); } }
#endif
            } else if (sub == 3) {
#ifndef NO_G2
                pg8::Gemm g{(const pg8::bf16_t*)(ws + WS_Y), (const pg8::bf16_t*)(ws + WS_WOUT) + (size_t)l * DM * DM, NTOK, DM, DM};
                pg8::StaticOrder S; S.init(NTOK, DM, nb, bid);
                EpiRes E{l == 0 ? p.x : p.out, p.out, 1.6817928305074290f};
                pg8::gemm_phase<EpiRes, pg8::StaticOrder>(lds, g, S, E, nullptr);
#endif
            } else {
#ifndef NO_LN
                ln_pass(p, l, tid, bid, nb);
#endif
            }
        }
        if (ph + 1 < p.ph_hi) cg::this_grid().sync();
    }
}

extern "C" void kernel_launch(void* const* d_in, const int* in_sizes, int n_in, void* d_out, int out_size, void* d_ws, size_t ws_size, hipStream_t stream) {
    static int grid = 0;
    if (grid == 0) {
        int dev = 0, cus = 0, per_cu = 0;
        hipGetDevice(&dev); hipDeviceGetAttribute(&cus, hipDeviceAttributeMultiprocessorCount, dev);
        if (hipFuncSetAttribute((const void*)fwd_kernel, hipFuncAttributeMaxDynamicSharedMemorySize, LDS_BYTES) != hipSuccess) fprintf(stderr, "kernel_launch: hipFuncSetAttribute failed\n");
        if (hipOccupancyMaxActiveBlocksPerMultiprocessor(&per_cu, (const void*)fwd_kernel, 512, LDS_BYTES) != hipSuccess || per_cu < 1) { fprintf(stderr, "kernel_launch: occupancy query says %d\n", per_cu); per_cu = 1; }
        (void)hipGetLastError();
        grid = cus * 1;
        if (ws_size < WS_END) fprintf(stderr, "kernel_launch: workspace too small: %zu < %zu\n", ws_size, (size_t)WS_END);
    }
    Prm p{};
    p.x = (const float*)d_in[0]; p.mem = (const float*)d_in[1]; p.pos = (const int*)d_in[2];
    p.w_in = (const float*)d_in[3]; p.ret_norm_g = (const float*)d_in[4]; p.mla_q_norm_g = (const float*)d_in[5]; p.mla_w_uq = (const float*)d_in[6]; p.mla_kv_norm_g = (const float*)d_in[7]; p.mla_w_ukv = (const float*)d_in[8];
    p.ml_conv_w = (const float*)d_in[9]; p.ml_conv_b = (const float*)d_in[10]; p.ml_w_q = (const float*)d_in[11]; p.ml_w_k = (const float*)d_in[12]; p.ml_i_bias = (const float*)d_in[13]; p.ml_f_bias = (const float*)d_in[14];
    p.ml_skip = (const float*)d_in[15]; p.ml_norm_g = (const float*)d_in[16]; p.w_mem_kv = (const float*)d_in[17]; p.w_out = (const float*)d_in[18]; p.ln_g = (const float*)d_in[19]; p.ln_b = (const float*)d_in[20];
    p.out = (float*)d_out; p.ws = (unsigned char*)d_ws;
#if N_LAUNCH_MODE == 1
    p.ph_lo = 0; p.ph_hi = NPHASE;
    void* args[] = {&p};
    hipError_t e = hipLaunchCooperativeKernel((const void*)fwd_kernel, dim3(grid), dim3(512), args, LDS_BYTES, stream);
    if (e != hipSuccess) fprintf(stderr, "cooperative launch failed: %s (grid %d)\n", hipGetErrorString(e), grid);
#else
    for (int ph = 0; ph < NPHASE; ++ph) { p.ph_lo = ph; p.ph_hi = ph + 1;
        hipLaunchKernelGGL(fwd_kernel, dim3(grid), dim3(512), LDS_BYTES, stream, p); }
#endif
}
```

```cpp
#include <hip/hip_runtime.h>
#include <hip/hip_cooperative_groups.h>
#include <cstdio>
namespace cg = cooperative_groups;
namespace pg8 {
#define PG8_LAS __attribute__((address_space(3)))
typedef unsigned short bf16_t;
typedef short bf16x8 __attribute__((ext_vector_type(8)));
typedef float f32x4 __attribute__((ext_vector_type(4)));
typedef unsigned u32x4 __attribute__((ext_vector_type(4)));
constexpr int BM = 256, BK = 64, HALF = 128, HTB = HALF * BK * 2  , STAGE_BYTES = 8 * HTB, NXCD = 8, WGM = 8;

__host__ __device__ __forceinline__ int lds_byte(int r, int c) { const int st = (r >> 4) * 2 + (c >> 5), rr = r & 15, cc = c & 31, ob = rr * 64 + cc * 2; return st * 1024 + (ob ^ (((ob >> 9) & 1) << 5)); }
__host__ __device__ __forceinline__ void stage_rc(int b, int& R, int& C) { const int st = b / 1024, sb = b % 1024, swz = sb ^ (((sb >> 9) & 1) << 5); R = (st >> 1) * 16 + swz / 64; C = (st & 1) * 32 + (swz % 64) / 2; }
__host__ __device__ __forceinline__ int perm32(int rho) { const int n = rho >> 4, i = rho & 15; return 8 * (i >> 2) + 4 * n + (i & 3); }

struct Unit { int pm, pn; };
struct Gemm { const bf16_t* A; const bf16_t* Bt; int M, N, K; };

struct StaticOrder {
    int nM, nN, nwg, G, c;
    __host__ __device__ void init(int M, int N, int G_, int c_) { nM = M / BM; nN = N / BM; nwg = nM * nN; G = G_; c = c_; }
    __host__ __device__ bool next(int i, Unit& u) const {
        const long L = (long)i * G + c; if (L >= nwg) return false;
        int wgid = (int)L; { const int q = nwg / NXCD, r = nwg % NXCD, xcd = wgid % NXCD, off = wgid / NXCD; wgid = (xcd < r ? xcd * (q + 1) : r * (q + 1) + (xcd - r) * q) + off; }
        const int nig = WGM * nN, gid = wgid / nig, fm = gid * WGM, gsz = (nM - fm) < WGM ? (nM - fm) : WGM;
        u.pm = fm + ((wgid % nig) % gsz); u.pn = (wgid % nig) / gsz; return true;
    }
    __device__ __forceinline__ void a_ready(const Unit&) const {}
    __device__ __forceinline__ void done(const Unit&) const {}
};
__device__ __forceinline__ unsigned cvt_pk_bf16(float lo, float hi) { unsigned r; asm volatile("v_cvt_pk_bf16_f32 %0, %1, %2" : "=v"(r) : "v"(lo), "v"(hi)); return r; }
typedef float f32x2 __attribute__((ext_vector_type(2)));
__device__ __forceinline__ f32x2 gelu_pk(f32x2 v) {
    const f32x2 av = __builtin_elementwise_abs(v), d = av * 0.2316418882f + 1.0f;
    f32x2 t; t.x = __builtin_amdgcn_rcpf(d.x); t.y = __builtin_amdgcn_rcpf(d.y);
    f32x2 q = t * 0.5307027145f + (-0.7265760135f); q = q * t + 0.7107068705f; q = q * t + (-0.142248368f); q = q * t + 0.127414796f; q = q * t;
    const f32x2 s = (v * v) * (-0.72134752044f);
    f32x2 e; e.x = __builtin_amdgcn_exp2f(s.x); e.y = __builtin_amdgcn_exp2f(s.y);
    const f32x2 m = v * (q * e), r = v - m;
    f32x2 o; o.x = v.x < 0.f ? m.x : r.x; o.y = v.y < 0.f ? m.y : r.y; return o;
}
template <int ACT  > struct EpiBf16 {
    static constexpr bool PERM = true, AFTER_DRAIN = false;
    bf16_t* O; int ldc; const float* bias; int split_cols; size_t split_stride;
    __device__ __forceinline__ void operator()(const f32x4 (&acc)[2][2][4][2], const Unit& u, int wr, int wc, int fr, int fq) const {
        const int row0 = u.pm * BM + wr * 64 + fr; int colt = u.pn * BM; bf16_t* base = O;
        if (split_cols) { const int t = colt / split_cols; base += (size_t)t * split_stride; colt -= t * split_cols; }
        const int col0 = colt + wc * 32 + 8 * fq, bcol0 = u.pn * BM + wc * 32 + 8 * fq;
        f32x4 bv[2][2];
#pragma unroll
        for (int bj = 0; bj < 2; ++bj)
#pragma unroll
            for (int n = 0; n < 2; ++n) bv[bj][n] = bias ? *(const f32x4*)(bias + bcol0 + bj * HALF + 4 * n) : (f32x4){0.f, 0.f, 0.f, 0.f};
#pragma unroll
        for (int ai = 0; ai < 2; ++ai)
#pragma unroll
            for (int m = 0; m < 4; ++m) { bf16_t* rowp = base + (size_t)(row0 + ai * HALF + m * 16) * ldc + col0;
#pragma unroll
                for (int bj = 0; bj < 2; ++bj) { f32x4 v0 = acc[ai][bj][m][0] + bv[bj][0], v1 = acc[ai][bj][m][1] + bv[bj][1];
                    if (ACT == 1) { f32x2 a = gelu_pk((f32x2){v0[0], v0[1]}), b = gelu_pk((f32x2){v0[2], v0[3]}), c = gelu_pk((f32x2){v1[0], v1[1]}), d = gelu_pk((f32x2){v1[2], v1[3]});
                        v0 = (f32x4){a.x, a.y, b.x, b.y}; v1 = (f32x4){c.x, c.y, d.x, d.y}; }
                    if (ACT == 2) {
#pragma unroll
                        for (int j = 0; j < 4; ++j) { v0[j] = 0.5f * v0[j] * (1.0f + erff(v0[j] * 0.70710678f)); v1[j] = 0.5f * v1[j] * (1.0f + erff(v1[j] * 0.70710678f)); } }
                    u32x4 w; w.x = cvt_pk_bf16(v0[0], v0[1]); w.y = cvt_pk_bf16(v0[2], v0[3]); w.z = cvt_pk_bf16(v1[0], v1[1]); w.w = cvt_pk_bf16(v1[2], v1[3]);
                    *(u32x4*)(rowp + bj * HALF) = w; } }
    }
};
template <class Epi, class Sched, bool STAMP = false>
__device__ __forceinline__ void gemm_phase(PG8_LAS unsigned char* lds, const Gemm g, const Sched& S, const Epi& E, unsigned long long* stamps) {
    const int tid = threadIdx.x, wid = __builtin_amdgcn_readfirstlane(tid >> 6), lane = tid & 63, wr = wid >> 2, wc = wid & 3, fr = lane & 15, fq = lane >> 4;
    const int K = g.K, nt = K / BK;
    int ts_lo = 0, ts_hi = 0, nts = 0; const unsigned long long rt_entry = STAMP ? (unsigned long long)wall_clock64() : 0ull;
#define PG8_STAMP() do { if (STAMP && wid == 0 && nts < 64) { const unsigned long long _c = (unsigned long long)clock64(); \
        ts_lo = (lane == nts) ? (int)(unsigned)_c : ts_lo; ts_hi = (lane == nts) ? (int)(unsigned)(_c >> 32) : ts_hi; ++nts; } } while (0)
    PG8_STAMP();
    unsigned voffA[2], voffB[2];
#pragma unroll
    for (int i = 0; i < 2; ++i) { int R, C; stage_rc(tid * 16 + i * 8192, R, C); const int Rb = Epi::PERM ? ((R & ~31) + perm32(R & 31)) : R;
        voffA[i] = (unsigned)(R * K + C) * 2u; voffB[i] = (unsigned)(Rb * K + C) * 2u; }
    const size_t kstep = (size_t)(BK * 2);
    const size_t hstep = (size_t)HALF * K * 2;
    const size_t tstep = 2 * hstep;
    const unsigned ldsw = (unsigned)wid * 1024u;
    const int aoff = lds_byte(wr * 64 + fr, fq * 8), boff = lds_byte(wc * 32 + fr, fq * 8);
#define PG8_SA(b, h) (((b) * 2 + (h)) * HTB)
#define PG8_SB(b, h) ((4 + (b) * 2 + (h)) * HTB)
#define PG8_STAGE(bufoff, gbase, voff) do { _Pragma("unroll") for (int _i = 0; _i < 2; ++_i) \
        __builtin_amdgcn_global_load_lds((const unsigned*)((const char*)(gbase) + (voff)[_i]), (PG8_LAS unsigned*)(lds + (bufoff) + ldsw + _i * 8192), 16, 0, 0); } while (0)
#define PG8_LDA(dst, b, h) do { _Pragma("unroll") for (int m = 0; m < 4; ++m) _Pragma("unroll") for (int k = 0; k < 2; ++k) dst[m][k] = *(const PG8_LAS bf16x8*)(lds + PG8_SA(b, h) + aoff + m * 2048 + k * 1024); } while (0)
#define PG8_LDB(dst, b, h) do { _Pragma("unroll") for (int n = 0; n < 2; ++n) _Pragma("unroll") for (int k = 0; k < 2; ++k) dst[n][k] = *(const PG8_LAS bf16x8*)(lds + PG8_SB(b, h) + boff + n * 2048 + k * 1024); } while (0)
#define PG8_MMA(ai, bj, At, Bt) do { __builtin_amdgcn_s_setprio(1); _Pragma("unroll") for (int m = 0; m < 4; ++m) _Pragma("unroll") for (int n = 0; n < 2; ++n) _Pragma("unroll") for (int k = 0; k < 2; ++k) \
        acc[ai][bj][m][n] = __builtin_amdgcn_mfma_f32_16x16x32_bf16(Bt[n][k], At[m][k], acc[ai][bj][m][n], 0, 0, 0); __builtin_amdgcn_s_setprio(0); } while (0)
#define PG8_WAIT_V(n) asm volatile("s_waitcnt vmcnt(" #n ")" ::: "memory")
#define PG8_WAIT_L(n) asm volatile("s_waitcnt lgkmcnt(" #n ")" ::: "memory")
#define PG8_BAR __builtin_amdgcn_s_barrier()
#define PG8_SCHED __builtin_amdgcn_sched_barrier(0)
    Unit cur, nxt; int ui = 0;
    if (!S.next(0, cur)) return;
    f32x4 acc[2][2][4][2];
#pragma unroll
    for (int a = 0; a < 2; ++a)
#pragma unroll
        for (int b = 0; b < 2; ++b)
#pragma unroll
            for (int m = 0; m < 4; ++m)
#pragma unroll
                for (int n = 0; n < 2; ++n) acc[a][b][m][n] = (f32x4){0.f, 0.f, 0.f, 0.f};
    bf16x8 At[4][2], B0[2][2], B1[2][2];
    const char* cA = (const char*)g.A + (size_t)cur.pm * tstep; const char* cB = (const char*)g.Bt + (size_t)cur.pn * tstep;
    S.a_ready(cur);
    PG8_STAGE(PG8_SB(0, 0), cB, voffB); PG8_STAGE(PG8_SA(0, 0), cA, voffA); PG8_STAGE(PG8_SB(0, 1), cB + hstep, voffB); PG8_STAGE(PG8_SA(0, 1), cA + hstep, voffA);
    if (wr == 1) PG8_BAR;
    PG8_WAIT_V(4); PG8_BAR;
    PG8_STAGE(PG8_SB(1, 0), cB + kstep, voffB); PG8_STAGE(PG8_SA(1, 0), cA + kstep, voffA); PG8_STAGE(PG8_SB(1, 1), cB + hstep + kstep, voffB);
    PG8_WAIT_V(6); PG8_BAR;
    PG8_STAMP();
    for (;;) {
        const bool has_next = S.next(ui + 1, nxt);
        const char* nA = has_next ? (const char*)g.A + (size_t)nxt.pm * tstep : cA; const char* nB = has_next ? (const char*)g.Bt + (size_t)nxt.pn * tstep : cB;
        for (int t = 0; t < nt; t += 2) {
            const bool last = (t == nt - 2);
            const char* a1 = cA + (size_t)(t + 1) * kstep;
            const char* a2 = last ? nA : cA + (size_t)(t + 2) * kstep; const char* b2 = last ? nB : cB + (size_t)(t + 2) * kstep;
            const char* a3 = a2 + kstep; const char* b3 = b2 + kstep;
            if (last && has_next) S.a_ready(nxt);
            PG8_LDB(B0, 0, 0); PG8_SCHED; PG8_LDA(At, 0, 0); PG8_STAGE(PG8_SA(1, 1), a1 + hstep, voffA);
            PG8_WAIT_L(8); PG8_BAR; PG8_WAIT_L(0); PG8_MMA(0, 0, At, B0); PG8_BAR; PG8_SCHED;
            PG8_LDB(B1, 0, 1); PG8_STAGE(PG8_SB(0, 0), b2, voffB);
            PG8_BAR; PG8_WAIT_L(0); PG8_MMA(0, 1, At, B1); PG8_BAR;
            PG8_LDA(At, 0, 1); PG8_STAGE(PG8_SA(0, 0), a2, voffA);
            PG8_BAR; PG8_WAIT_L(0); PG8_MMA(1, 0, At, B0); PG8_BAR; PG8_SCHED;
            PG8_STAGE(PG8_SB(0, 1), b2 + hstep, voffB);
            PG8_WAIT_V(6); PG8_BAR; PG8_MMA(1, 1, At, B1); PG8_BAR;
            PG8_LDB(B0, 1, 0); PG8_SCHED; PG8_LDA(At, 1, 0); PG8_STAGE(PG8_SA(0, 1), a2 + hstep, voffA);
            PG8_WAIT_L(8); PG8_BAR; PG8_WAIT_L(0); PG8_MMA(0, 0, At, B0); PG8_BAR; PG8_SCHED;
            PG8_LDB(B1, 1, 1); PG8_STAGE(PG8_SB(1, 0), b3, voffB);
            PG8_BAR; PG8_WAIT_L(0); PG8_MMA(0, 1, At, B1); PG8_BAR;
            PG8_LDA(At, 1, 1); PG8_STAGE(PG8_SA(1, 0), a3, voffA);
            PG8_BAR; PG8_WAIT_L(0); PG8_MMA(1, 0, At, B0); PG8_BAR; PG8_SCHED;
            PG8_STAGE(PG8_SB(1, 1), b3 + hstep, voffB);
            PG8_WAIT_V(6); PG8_BAR; PG8_MMA(1, 1, At, B1); PG8_BAR;
        }
        PG8_STAMP();
        if constexpr (!Epi::AFTER_DRAIN) { E(acc, cur, wr, wc, fr, fq); S.done(cur); }
        PG8_STAMP();
        if (!has_next) break;
#pragma unroll
        for (int a = 0; a < 2; ++a)
#pragma unroll
            for (int b = 0; b < 2; ++b)
#pragma unroll
                for (int m = 0; m < 4; ++m)
#pragma unroll
                    for (int n = 0; n < 2; ++n) acc[a][b][m][n] = (f32x4){0.f, 0.f, 0.f, 0.f};
        cur = nxt; cA = nA; cB = nB; ++ui;
    }
    PG8_WAIT_V(0);
    if (wr == 0) PG8_BAR;
    PG8_BAR;
    if constexpr (Epi::AFTER_DRAIN) { E.fused(acc, cur, wr, wc, fr, fq, lds, wid, lane); S.done(cur); }
    PG8_STAMP();
    if (STAMP && wid == 0) { stamps[lane] = lane < nts ? (((unsigned long long)(unsigned)ts_hi << 32) | (unsigned)ts_lo) : 0ull;
        if (lane == 62) stamps[62] = rt_entry; if (lane == 63) stamps[63] = (unsigned long long)wall_clock64(); }
#undef PG8_STAMP
#undef PG8_SA
#undef PG8_SB
#undef PG8_STAGE
#undef PG8_LDA
#undef PG8_LDB
#undef PG8_MMA
#undef PG8_WAIT_V
#undef PG8_WAIT_L
#undef PG8_BAR
#undef PG8_SCHED
}
}

#ifndef N_LAUNCH_MODE
#define N_LAUNCH_MODE 1
#endif
#define LAS __attribute__((address_space(3)))
typedef unsigned short bf16_t;
typedef short bf16x8 __attribute__((ext_vector_type(8)));
typedef float f32x4 __attribute__((ext_vector_type(4)));
typedef unsigned u32x4 __attribute__((ext_vector_type(4)));
typedef unsigned u32x2 __attribute__((ext_vector_type(2)));

constexpr int NTOK = 16384, DM = 2048, SEQ = 2048, NB = 8, DEPTH = 4;
constexpr int HLD = 6144;
constexpr int NIN = 6400;
constexpr int C_RQ = 0, C_RK = 512, C_RV = 1024, C_ACQ = 1536, C_ACKV = 1920, C_LX = 2048, C_LV = 2560, C_LO = 3072, C_CQ = 3584, C_Z = 4096;
constexpr int S_KPE = 0, S_LI = 64, S_LF = 68;
constexpr int TS = 136, TS2 = 200;
constexpr int REG = 128 * TS * 2;
constexpr int MISC_OFF = 4 * REG;
constexpr int LDS_BYTES = MISC_OFF + 4096;
constexpr int NPHASE = 1 + 5 * DEPTH;

constexpr size_t AL(size_t x) { return (x + 255) & ~(size_t)255; }
constexpr size_t WS_WIN = 0;
constexpr size_t WS_WOUT = WS_WIN + AL((size_t)DEPTH * NIN * DM * 2);
constexpr size_t WS_WMEM = WS_WOUT + AL((size_t)DEPTH * DM * DM * 2);
constexpr size_t WS_WUQ = WS_WMEM + AL((size_t)DEPTH * 1024 * DM * 2);
constexpr size_t WS_WUKV = WS_WUQ + AL((size_t)DEPTH * 768 * 384 * 2);
constexpr size_t WS_WQ = WS_WUKV + AL((size_t)DEPTH * 1024 * 128 * 2);
constexpr size_t WS_WK = WS_WQ + AL((size_t)DEPTH * 4 * 128 * 128 * 2);
constexpr size_t WS_XN = WS_WK + AL((size_t)DEPTH * 4 * 128 * 128 * 2);
constexpr size_t WS_MEMB = WS_XN + AL((size_t)NTOK * DM * 2);
constexpr size_t WS_H = WS_MEMB + AL((size_t)2048 * DM * 2);
constexpr size_t WS_HS = WS_H + AL((size_t)NTOK * HLD * 2);
constexpr size_t WS_MKV = WS_HS + AL((size_t)NTOK * 256 * 4);
constexpr size_t WS_URT = WS_MKV + AL((size_t)2048 * 1024 * 2);
constexpr size_t WS_ULT = WS_URT + AL((size_t)512 * 16384 * 2);
constexpr size_t WS_NV = WS_ULT + AL((size_t)512 * 16384 * 2);
constexpr size_t WS_GSC = WS_NV + AL((size_t)512 * 128 * 4);
constexpr size_t WS_LQ = WS_GSC + AL((size_t)512 * 2 * 4);
constexpr size_t WS_LK = WS_LQ + AL((size_t)NTOK * 512 * 2);
constexpr size_t WS_XC = WS_LK + AL((size_t)NTOK * 512 * 2);
constexpr size_t WS_QA = WS_XC + AL((size_t)NTOK * 512 * 2);
constexpr size_t WS_KA = WS_QA + AL((size_t)NTOK * 4 * 192 * 2);
constexpr size_t WS_VAT = WS_KA + AL((size_t)NTOK * 4 * 192 * 2);
constexpr size_t WS_Y = WS_VAT + AL((size_t)NTOK * 512 * 2);
constexpr size_t WS_ROPE64 = WS_Y + AL((size_t)NTOK * DM * 2);
constexpr size_t WS_ROPE32 = WS_ROPE64 + AL((size_t)NTOK * 64 * 8);
constexpr size_t WS_END = WS_ROPE32 + AL((size_t)NTOK * 32 * 8);

struct Prm {
    const float* x; const float* mem; const int* pos;
    const float* w_in; const float* ret_norm_g; const float* mla_q_norm_g; const float* mla_w_uq; const float* mla_kv_norm_g; const float* mla_w_ukv;
    const float* ml_conv_w; const float* ml_conv_b; const float* ml_w_q; const float* ml_w_k; const float* ml_i_bias; const float* ml_f_bias; const float* ml_skip; const float* ml_norm_g;
    const float* w_mem_kv; const float* w_out; const float* ln_g; const float* ln_b;
    float* out; unsigned char* ws;
    int ph_lo, ph_hi;
};

__device__ __forceinline__ float bf2f(bf16_t b) { return __uint_as_float(((unsigned)b) << 16); }
__device__ __forceinline__ bf16_t f2bf(float f) { unsigned u = __float_as_uint(f); u += 0x7FFFu + ((u >> 16) & 1u); return (bf16_t)(u >> 16); }
__device__ __forceinline__ unsigned pk2(float lo, float hi) { return pg8::cvt_pk_bf16(lo, hi); }
__device__ __forceinline__ float lo16(unsigned w) { return __uint_as_float(w << 16); }
__device__ __forceinline__ float hi16(unsigned w) { return __uint_as_float(w & 0xffff0000u); }
__device__ __forceinline__ float siluf(float v) { return v / (1.0f + __expf(-v)); }
__device__ __forceinline__ float sigmf(float v) { return 1.0f / (1.0f + __expf(-v)); }
__device__ __forceinline__ float rsum4(float v) { v += __shfl_xor(v, 16); v += __shfl_xor(v, 32); return v; }
__device__ __forceinline__ float rmax4(float v) { v = fmaxf(v, __shfl_xor(v, 16)); v = fmaxf(v, __shfl_xor(v, 32)); return v; }

struct EpiH {
    static constexpr bool PERM = true, AFTER_DRAIN = false;
    bf16_t* H; float* HS;
    __device__ __forceinline__ void operator()(const pg8::f32x4 (&acc)[2][2][4][2], const pg8::Unit& u, int wr, int wc, int fr, int fq) const {
        const int row0 = u.pm * 256 + wr * 64 + fr;
        if (u.pn < 24) {
            const int col0 = u.pn * 256 + wc * 32 + 8 * fq;
#pragma unroll
            for (int ai = 0; ai < 2; ++ai)
#pragma unroll
                for (int m = 0; m < 4; ++m) { bf16_t* rowp = H + (size_t)(row0 + ai * 128 + m * 16) * HLD + col0;
#pragma unroll
                    for (int bj = 0; bj < 2; ++bj) { const pg8::f32x4 v0 = acc[ai][bj][m][0], v1 = acc[ai][bj][m][1];
                        u32x4 w; w.x = pk2(v0[0], v0[1]); w.y = pk2(v0[2], v0[3]); w.z = pk2(v1[0], v1[1]); w.w = pk2(v1[2], v1[3]);
                        *(u32x4*)(rowp + bj * 128) = w; } }
        } else {
            const int col0 = wc * 32 + 8 * fq;
#pragma unroll
            for (int ai = 0; ai < 2; ++ai)
#pragma unroll
                for (int m = 0; m < 4; ++m) { float* rowp = HS + (size_t)(row0 + ai * 128 + m * 16) * 256 + col0;
#pragma unroll
                    for (int bj = 0; bj < 2; ++bj)
#pragma unroll
                        for (int n = 0; n < 2; ++n) *(pg8::f32x4*)(rowp + bj * 128 + 4 * n) = acc[ai][bj][m][n]; }
        }
    }
};
struct EpiRes {
    static constexpr bool PERM = false, AFTER_DRAIN = false;
    const float* X; float* T; float alpha;
    __device__ __forceinline__ void operator()(const pg8::f32x4 (&acc)[2][2][4][2], const pg8::Unit& u, int wr, int wc, int fr, int fq) const {
        const int row0 = u.pm * 256 + wr * 64 + fr, col0 = u.pn * 256 + wc * 32 + 4 * fq;
#pragma unroll
        for (int ai = 0; ai < 2; ++ai)
#pragma unroll
            for (int m = 0; m < 4; ++m) { const size_t off = (size_t)(row0 + ai * 128 + m * 16) * DM + col0;
#pragma unroll
                for (int bj = 0; bj < 2; ++bj)
#pragma unroll
                    for (int n = 0; n < 2; ++n) { const size_t o = off + bj * 128 + n * 16; const pg8::f32x4 xv = *(const pg8::f32x4*)(X + o);
                        *(pg8::f32x4*)(T + o) = xv * alpha + acc[ai][bj][m][n]; } }
    }
};

template <int ROWS, int COLS>
__device__ __forceinline__ void ld_tile(LAS bf16_t* dst, int ldl, const bf16_t* src, size_t ldg, int tid) {
    constexpr int CH = COLS / 8, TOT = ROWS * CH;
#pragma unroll
    for (int i0 = 0; i0 < TOT; i0 += 512) { const int i = i0 + tid; if (TOT % 512 == 0 || i < TOT) { const int r = i / CH, c = i % CH;
        const u32x4 v = *(const u32x4*)(src + (size_t)r * ldg + c * 8);
        *(LAS u32x4*)(dst + r * ldl + c * 8) = v; } }
}
template <int ROWS, int COLS>
__device__ __forceinline__ void ld_tile_T(LAS bf16_t* dst, int ldl, const bf16_t* src, size_t ldg, int tid) {
    constexpr int CH = COLS / 8, TOT = ROWS * CH;
#pragma unroll
    for (int i0 = 0; i0 < TOT; i0 += 512) { const int i = i0 + tid; const int r = i % ROWS, c = i / ROWS;
        const u32x4 v = *(const u32x4*)(src + (size_t)r * ldg + c * 8);
        LAS bf16_t* d = dst + (c * 8) * ldl + r;
        d[0] = (bf16_t)(v.x & 0xffffu); d[ldl] = (bf16_t)(v.x >> 16); d[2 * ldl] = (bf16_t)(v.y & 0xffffu); d[3 * ldl] = (bf16_t)(v.y >> 16);
        d[4 * ldl] = (bf16_t)(v.z & 0xffffu); d[5 * ldl] = (bf16_t)(v.z >> 16); d[6 * ldl] = (bf16_t)(v.w & 0xffffu); d[7 * ldl] = (bf16_t)(v.w >> 16); }
}
template <int NT, int KS>
__device__ __forceinline__ void mma_slab(f32x4 (&acc)[NT], const LAS bf16_t* A, int lda, const LAS bf16_t* Bt, int ldb, int lane) {
    const int r = lane & 15, q = lane >> 4;
    const LAS bf16_t* ap = A + r * lda + q * 8; const LAS bf16_t* bp = Bt + r * ldb + q * 8;
#pragma unroll
    for (int ks = 0; ks < KS; ++ks) { const bf16x8 a = *(const LAS bf16x8*)(ap + ks * 32);
#pragma unroll
        for (int t = 0; t < NT; ++t) { const bf16x8 b = *(const LAS bf16x8*)(bp + t * 16 * ldb + ks * 32);
            acc[t] = __builtin_amdgcn_mfma_f32_16x16x32_bf16(b, a, acc[t], 0, 0, 0); } }
}
template <int NT, int KS>
__device__ __forceinline__ void mma_slab_ra(f32x4 (&acc)[NT], const bf16x8 (&af)[KS], const LAS bf16_t* Bt, int ldb, int lane) {
    const int r = lane & 15, q = lane >> 4; const LAS bf16_t* bp = Bt + r * ldb + q * 8;
#pragma unroll
    for (int ks = 0; ks < KS; ++ks)
#pragma unroll
        for (int t = 0; t < NT; ++t) { const bf16x8 b = *(const LAS bf16x8*)(bp + t * 16 * ldb + ks * 32);
            acc[t] = __builtin_amdgcn_mfma_f32_16x16x32_bf16(b, af[ks], acc[t], 0, 0, 0); }
}
template <int NT, int KS>
__device__ __forceinline__ void mma_slab_n(f32x4 (&acc)[NT], const LAS bf16_t* A, int lda, const LAS bf16_t* Bt, int ldb, int lane) {
    const int r = lane & 15, q = lane >> 4;
    const LAS bf16_t* ap = A + r * lda + q * 8; const LAS bf16_t* bp = Bt + r * ldb + q * 8;
#pragma unroll
    for (int ks = 0; ks < KS; ++ks) { const bf16x8 a = *(const LAS bf16x8*)(ap + ks * 32);
#pragma unroll
        for (int t = 0; t < NT; ++t) { const bf16x8 b = *(const LAS bf16x8*)(bp + t * 16 * ldb + ks * 32);
            acc[t] = __builtin_amdgcn_mfma_f32_16x16x32_bf16(a, b, acc[t], 0, 0, 0); } }
}
template <int NT> __device__ __forceinline__ void zero_acc(f32x4 (&acc)[NT]) {
#pragma unroll
    for (int t = 0; t < NT; ++t) acc[t] = (f32x4){0.f, 0.f, 0.f, 0.f};
}
__device__ __forceinline__ void rope_sc(int pos, int k, float inv_half_log2theta, float& s, float& c) {
    const float fr = exp2f(-(float)k * inv_half_log2theta);
    const float ang = (float)pos * fr;
    const float n = rintf(ang * 0.15915494309189535f);
    float r = fmaf(-n, 6.28125f, ang); r = fmaf(-n, 1.9353071795864769e-3f, r);
    s = sinf(r); c = cosf(r);
}
constexpr float LOG2_THETA = 13.287712379549449f;
typedef float f32x2 __attribute__((ext_vector_type(2)));
template <int HALF>
__device__ __forceinline__ void rope_lds(LAS bf16_t* T, int ld, int c0, const f32x2* tab, float scale, int tid) {
    for (int i = tid; i < 128 * HALF; i += 512) { const int tok = i / HALF, k = i % HALF; const f32x2 cs_ = tab[i]; const float c = cs_.x, s = cs_.y;
        LAS bf16_t* p = T + tok * ld + c0 + k; const float x1 = bf2f(p[0]), x2 = bf2f(p[HALF]);
        p[0] = f2bf((x1 * c - x2 * s) * scale); p[HALF] = f2bf((x2 * c + x1 * s) * scale); }
}
__device__ __forceinline__ float ret_log2g(int h) { return log2f(1.0f - exp2f(-5.0f - (float)h)); }
__device__ __forceinline__ float logsig(float f) { return fminf(f, 0.f) - log1pf(expf(-fabsf(f))); }

__device__ __forceinline__ float scan128_sum(float v, LAS float* tmp, int tid) {
    const int lane = tid & 63, w = tid >> 6;
#pragma unroll
    for (int o = 1; o < 64; o <<= 1) { const float u = __shfl_up(v, o); if (lane >= o) v += u; }
    if (lane == 63 && w < 2) tmp[w] = v;
    __syncthreads();
    if (w == 1) v += tmp[0];
    __syncthreads();
    return v;
}
__device__ __forceinline__ float scan128_max(float v, LAS float* tmp, int tid, float& tot) {
    const int lane = tid & 63, w = tid >> 6;
#pragma unroll
    for (int o = 1; o < 64; o <<= 1) { const float u = __shfl_up(v, o); if (lane >= o) v = fmaxf(v, u); }
    if (lane == 63 && w < 2) tmp[w] = v;
    __syncthreads();
    const float t0 = tmp[0], t1 = tmp[1];
    if (w == 1) v = fmaxf(v, t0);
    tot = fmaxf(t0, t1);
    __syncthreads();
    return v;
}
__device__ __forceinline__ void head_norm(f32x4 (&o)[8]) {
    float s = 0.f;
#pragma unroll
    for (int t = 0; t < 8; ++t) s += (o[t][0] + o[t][1]) + (o[t][2] + o[t][3]);
    const float mean = rsum4(s) * (1.0f / 128.0f); float q = 0.f;
#pragma unroll
    for (int t = 0; t < 8; ++t) { o[t] = o[t] - mean; q += (o[t][0] * o[t][0] + o[t][1] * o[t][1]) + (o[t][2] * o[t][2] + o[t][3] * o[t][3]); }
    const float rstd = rsqrtf(rsum4(q) * (1.0f / 128.0f) + 1e-5f);
#pragma unroll
    for (int t = 0; t < 8; ++t) o[t] = o[t] * rstd;
}

__device__ __forceinline__ int win_colmap(int n) {
    if (n < 2048) return n;
    if (n < 3584) return n + 64;
    if (n < 6144) return n + 72;
    if (n < 6208) return n - 6144 + 2048;
    if (n < 6216) return n - 6208 + 3648;
    return -1;
}
template <bool MAP>
__device__ __forceinline__ void conv_T(const float* src, int ldsrc, bf16_t* dst, int N, int K, const float* rowscale, LAS float* tile, int tid, int bid, int nb) {
    const int ntn = N / 64, ntiles = ntn * (K / 64);
    for (int ti = bid; ti < ntiles; ti += nb) { const int nt = ti % ntn, kt = ti / ntn;
        __syncthreads();
#pragma unroll
        for (int i = 0; i < 8; ++i) { const int r = (tid >> 6) + 8 * i, cc = tid & 63; const int n = nt * 64 + cc; const int oc = MAP ? win_colmap(n) : n;
            float v = oc >= 0 ? src[(size_t)(kt * 64 + r) * ldsrc + oc] : 0.f; if (rowscale) v *= rowscale[kt * 64 + r];
            tile[r * 65 + cc] = v; }
        __syncthreads();
#pragma unroll
        for (int i = 0; i < 8; ++i) { const int cc = (tid >> 6) + 8 * i, r = tid & 63;
            dst[(size_t)(nt * 64 + cc) * K + kt * 64 + r] = f2bf(tile[r * 65 + cc]); }
    }
}
__device__ __forceinline__ void cvt_flat(const float* src, bf16_t* dst, size_t n, int tid, int bid, int nb) {
    for (size_t i = ((size_t)bid * 512 + tid) * 8; i < n; i += (size_t)nb * 512 * 8) {
        const f32x4 a = *(const f32x4*)(src + i), b = *(const f32x4*)(src + i + 4);
        u32x4 w; w.x = pk2(a[0], a[1]); w.y = pk2(a[2], a[3]); w.z = pk2(b[0], b[1]); w.w = pk2(b[2], b[3]);
        *(u32x4*)(dst + i) = w; }
}
__device__ void phase0(const Prm& p, LAS unsigned char* lds, int tid, int bid, int nb) {
    asm volatile("" : "+v"(tid)); unsigned char* wsl = p.ws; asm volatile("" : "+s"(wsl));
    LAS float* tile = (LAS float*)lds;
    unsigned char* ws = wsl;
    for (int l = 0; l < DEPTH; ++l) {
        conv_T<true>(p.w_in + (size_t)l * DM * 6216, 6216, (bf16_t*)(ws + WS_WIN) + (size_t)l * NIN * DM, NIN, DM, nullptr, tile, tid, bid, nb);
        conv_T<false>(p.w_out + (size_t)l * DM * DM, DM, (bf16_t*)(ws + WS_WOUT) + (size_t)l * DM * DM, DM, DM, nullptr, tile, tid, bid, nb);
        conv_T<false>(p.w_mem_kv + (size_t)l * DM * 1024, 1024, (bf16_t*)(ws + WS_WMEM) + (size_t)l * 1024 * DM, 1024, DM, nullptr, tile, tid, bid, nb);
        conv_T<false>(p.mla_w_uq + (size_t)l * 384 * 768, 768, (bf16_t*)(ws + WS_WUQ) + (size_t)l * 768 * 384, 768, 384, p.mla_q_norm_g + l * 384, tile, tid, bid, nb);
        conv_T<false>(p.mla_w_ukv + (size_t)l * 128 * 1024, 1024, (bf16_t*)(ws + WS_WUKV) + (size_t)l * 1024 * 128, 1024, 128, p.mla_kv_norm_g + l * 128, tile, tid, bid, nb);
        for (int h = 0; h < 4; ++h) {
            conv_T<false>(p.ml_w_q + (size_t)(l * 4 + h) * 16384, 128, (bf16_t*)(ws + WS_WQ) + (size_t)(l * 4 + h) * 16384, 128, 128, nullptr, tile, tid, (bid + 8 * h + 32 * l) % nb, nb);
            conv_T<false>(p.ml_w_k + (size_t)(l * 4 + h) * 16384, 128, (bf16_t*)(ws + WS_WK) + (size_t)(l * 4 + h) * 16384, 128, 128, nullptr, tile, tid, (bid + 8 * h + 32 * l + 4) % nb, nb);
        }
    }
    for (int i = bid * 512 + tid; i < NTOK * 64; i += nb * 512) { float sn, cs; rope_sc(p.pos[i >> 6], i & 63, LOG2_THETA / 64.f, sn, cs); ((f32x2*)(ws + WS_ROPE64))[i] = (f32x2){cs, sn}; }
    for (int i = bid * 512 + tid; i < NTOK * 32; i += nb * 512) { float sn, cs; rope_sc(p.pos[i >> 5], i & 31, LOG2_THETA / 32.f, sn, cs); ((f32x2*)(ws + WS_ROPE32))[i] = (f32x2){cs, sn}; }
    cvt_flat(p.x, (bf16_t*)(ws + WS_XN), (size_t)NTOK * DM, tid, bid, nb);
    cvt_flat(p.mem, (bf16_t*)(ws + WS_MEMB), (size_t)2048 * DM, tid, bid, nb);
}

__device__ void ret_state(const Prm& p, LAS unsigned char* lds, int idx, int tid) {
    asm volatile("" : "+v"(tid)); unsigned char* wsl = p.ws; asm volatile("" : "+s"(wsl));
    const int c = idx & 15, h = (idx >> 4) & 3, b = idx >> 6, lane = tid & 63, w = tid >> 6;
    const size_t row0 = (size_t)b * SEQ + c * 128;
    const bf16_t* H = (const bf16_t*)(wsl + WS_H);
    LAS bf16_t* Ks = (LAS bf16_t*)lds; LAS bf16_t* KT = (LAS bf16_t*)(lds + REG); LAS bf16_t* VT = (LAS bf16_t*)(lds + 2 * REG);
    __syncthreads();
    ld_tile<128, 128>(Ks, TS, H + row0 * HLD + C_RK + h * 128, HLD, tid);
    ld_tile_T<128, 128>(VT, TS, H + row0 * HLD + C_RV + h * 128, HLD, tid);
    __syncthreads();
    const float lg2 = ret_log2g(h); const f32x2* tab = (const f32x2*)(wsl + WS_ROPE64) + row0 * 64;
    for (int i = tid; i < 128 * 64; i += 512) { const int tok = i & 127, k = i >> 7; const f32x2 cs_ = tab[tok * 64 + k]; const float cs = cs_.x, s = cs_.y;
        const float x1 = bf2f(Ks[tok * TS + k]), x2 = bf2f(Ks[tok * TS + k + 64]);
        const float dk = exp2f(lg2 * (float)(127 - tok)) * 0.08838834764831845f;
        KT[k * TS + tok] = f2bf((x1 * cs - x2 * s) * dk); KT[(k + 64) * TS + tok] = f2bf((x2 * cs + x1 * s) * dk); }
    __syncthreads();
    f32x4 acc[8]; zero_acc(acc);
    mma_slab<8, 4>(acc, VT + (w * 16) * TS, TS, KT, TS, lane);
    bf16_t* U = (bf16_t*)(wsl + WS_URT) + (size_t)idx * 16384 + (w * 16 + (lane & 15)) * 128 + (lane >> 4) * 4;
#pragma unroll
    for (int t = 0; t < 8; ++t) { u32x2 v; v.x = pk2(acc[t][0], acc[t][1]); v.y = pk2(acc[t][2], acc[t][3]); *(u32x2*)(U + t * 16) = v; }
}

__device__ void mlstm_state(const Prm& p, LAS unsigned char* lds, int l, int idx, int tid) {
    asm volatile("" : "+v"(tid)); unsigned char* wsl = p.ws; asm volatile("" : "+s"(wsl));
    const int c = idx & 15, h = (idx >> 4) & 3, b = idx >> 6, lane = tid & 63, w = tid >> 6;
    const size_t row0 = (size_t)b * SEQ + c * 128;
    const bf16_t* H = (const bf16_t*)(wsl + WS_H); const float* HS = (const float*)(wsl + WS_HS);
    LAS bf16_t* XCs = (LAS bf16_t*)lds; LAS bf16_t* W = (LAS bf16_t*)(lds + REG); LAS bf16_t* VT = (LAS bf16_t*)(lds + 2 * REG); LAS bf16_t* KT = (LAS bf16_t*)(lds + 3 * REG);
    LAS float* lf = (LAS float*)(lds + MISC_OFF); LAS float* al = lf + 128; LAS float* wk = lf + 256;
    __syncthreads();
    const float lfv = tid < 128 ? logsig(HS[(row0 + tid) * 256 + S_LF + h] + p.ml_f_bias[l * 4 + h]) : 0.f;
    const float ipv = tid < 128 ? HS[(row0 + tid) * 256 + S_LI + h] + p.ml_i_bias[l * 4 + h] : 0.f;
    for (int i = tid; i < 128 * 16; i += 512) { const int tok = i >> 4, ch8 = (i & 15) * 8; const int chg = h * 128 + ch8;
        float a[8];
        { const f32x4 b0 = *(const f32x4*)(p.ml_conv_b + l * 512 + chg), b1 = *(const f32x4*)(p.ml_conv_b + l * 512 + chg + 4);
          a[0] = b0[0]; a[1] = b0[1]; a[2] = b0[2]; a[3] = b0[3]; a[4] = b1[0]; a[5] = b1[1]; a[6] = b1[2]; a[7] = b1[3]; }
#pragma unroll
        for (int jj = 0; jj < 4; ++jj) { const int t = c * 128 + tok - 3 + jj;
            if (t >= 0) { const u32x4 xv = *(const u32x4*)(H + ((size_t)b * SEQ + t) * HLD + C_LX + chg);
                const float* wp = p.ml_conv_w + ((size_t)l * 4 + jj) * 512 + chg; const f32x4 w0 = *(const f32x4*)wp, w1 = *(const f32x4*)(wp + 4);
                a[0] += w0[0] * lo16(xv.x); a[1] += w0[1] * hi16(xv.x); a[2] += w0[2] * lo16(xv.y); a[3] += w0[3] * hi16(xv.y);
                a[4] += w1[0] * lo16(xv.z); a[5] += w1[1] * hi16(xv.z); a[6] += w1[2] * lo16(xv.w); a[7] += w1[3] * hi16(xv.w); } }
        u32x4 o; o.x = pk2(siluf(a[0]), siluf(a[1])); o.y = pk2(siluf(a[2]), siluf(a[3])); o.z = pk2(siluf(a[4]), siluf(a[5])); o.w = pk2(siluf(a[6]), siluf(a[7]));
        *(LAS u32x4*)(XCs + tok * TS + ch8) = o;
        *(u32x4*)((bf16_t*)(wsl + WS_XC) + (row0 + tok) * 512 + chg) = o; }
    ld_tile<128, 128>(W, TS, (const bf16_t*)(wsl + WS_WQ) + (size_t)(l * 4 + h) * 16384, 128, tid);
    ld_tile_T<128, 128>(VT, TS, H + row0 * HLD + C_LV + h * 128, HLD, tid);
    __syncthreads();
    const float cum = scan128_sum(lfv, lf, tid);
    const float alv = tid < 128 ? ipv - cum : -3.0e38f;
    float mloc; (void)scan128_max(alv, lf, tid, mloc);
    if (tid < 128) wk[tid] = expf(alv - mloc);
    if (tid == 127) { float* g = (float*)(wsl + WS_GSC) + idx * 2; g[0] = cum; g[1] = mloc; }
    const int tok = w * 16 + (lane & 15), q4 = (lane >> 4) * 4;
    const size_t hb = ((size_t)(b * 4 + h) * SEQ + c * 128 + tok) * 128 + q4;
    {   f32x4 acc[8]; zero_acc(acc);
        mma_slab<8, 4>(acc, XCs + (w * 16) * TS, TS, W, TS, lane);
        bf16_t* o = (bf16_t*)(wsl + WS_LQ) + hb;
#pragma unroll
        for (int t = 0; t < 8; ++t) { u32x2 v; v.x = pk2(acc[t][0], acc[t][1]); v.y = pk2(acc[t][2], acc[t][3]); *(u32x2*)(o + t * 16) = v; } }
    __syncthreads();
    ld_tile<128, 128>(W, TS, (const bf16_t*)(wsl + WS_WK) + (size_t)(l * 4 + h) * 16384, 128, tid);
    __syncthreads();
    {   f32x4 acc[8]; zero_acc(acc);
        mma_slab<8, 4>(acc, XCs + (w * 16) * TS, TS, W, TS, lane);
        bf16_t* o = (bf16_t*)(wsl + WS_LK) + hb; const float wt = wk[tok];
#pragma unroll
        for (int t = 0; t < 8; ++t) { acc[t] = acc[t] * 0.08838834764831845f;
            u32x2 v; v.x = pk2(acc[t][0], acc[t][1]); v.y = pk2(acc[t][2], acc[t][3]); *(u32x2*)(o + t * 16) = v;
#pragma unroll
            for (int j = 0; j < 4; ++j) KT[(t * 16 + q4 + j) * TS + tok] = f2bf(acc[t][j] * wt); } }
    __syncthreads();
    if (tid < 128) { float s = 0.f; for (int r = 0; r < 128; ++r) s += bf2f(KT[tid * TS + r]); ((float*)(wsl + WS_NV))[idx * 128 + tid] = s; }
    {   f32x4 acc[8]; zero_acc(acc);
        mma_slab<8, 4>(acc, VT + (w * 16) * TS, TS, KT, TS, lane);
        bf16_t* U = (bf16_t*)(wsl + WS_ULT) + (size_t)idx * 16384 + (w * 16 + (lane & 15)) * 128 + q4;
#pragma unroll
        for (int t = 0; t < 8; ++t) { u32x2 v; v.x = pk2(acc[t][0], acc[t][1]); v.y = pk2(acc[t][2], acc[t][3]); *(u32x2*)(U + t * 16) = v; } }
}

__device__ void mla_proj(const Prm& p, LAS unsigned char* lds, int l, int idx, int tid) {
    asm volatile("" : "+v"(tid)); unsigned char* wsl = p.ws; asm volatile("" : "+s"(wsl));
    const int h = idx & 3, tt = idx >> 2, b = tt >> 4, t0 = (tt & 15) * 128, lane = tid & 63, w = tid >> 6;
    const size_t row0 = (size_t)tt * 128;
    const bf16_t* H = (const bf16_t*)(wsl + WS_H); const float* HS = (const float*)(wsl + WS_HS);
    LAS bf16_t* As = (LAS bf16_t*)lds; LAS bf16_t* Bs = (LAS bf16_t*)(lds + REG);
    LAS float* rsq = (LAS float*)(lds + MISC_OFF); LAS float* rskv = rsq + 128;
    __syncthreads();
    {   const int r = tid >> 2, part = tid & 3; const bf16_t* rp = H + (row0 + r) * HLD; float ss = 0.f, s2 = 0.f;
#pragma unroll
        for (int i = 0; i < 12; ++i) { const u32x4 v = *(const u32x4*)(rp + C_ACQ + part * 96 + i * 8);
            ss += lo16(v.x) * lo16(v.x) + hi16(v.x) * hi16(v.x) + lo16(v.y) * lo16(v.y) + hi16(v.y) * hi16(v.y) + lo16(v.z) * lo16(v.z) + hi16(v.z) * hi16(v.z) + lo16(v.w) * lo16(v.w) + hi16(v.w) * hi16(v.w); }
#pragma unroll
        for (int i = 0; i < 4; ++i) { const u32x4 v = *(const u32x4*)(rp + C_ACKV + part * 32 + i * 8);
            s2 += lo16(v.x) * lo16(v.x) + hi16(v.x) * hi16(v.x) + lo16(v.y) * lo16(v.y) + hi16(v.y) * hi16(v.y) + lo16(v.z) * lo16(v.z) + hi16(v.z) * hi16(v.z) + lo16(v.w) * lo16(v.w) + hi16(v.w) * hi16(v.w); }
        ss += __shfl_xor(ss, 1); ss += __shfl_xor(ss, 2); s2 += __shfl_xor(s2, 1); s2 += __shfl_xor(s2, 2);
        if (part == 0) { rsq[r] = rsqrtf(ss * (1.0f / 384.0f) + 1e-6f); rskv[r] = rsqrtf(s2 * (1.0f / 128.0f) + 1e-6f); } }
    const int tok = w * 16 + (lane & 15), q4 = (lane >> 4) * 4;
    const size_t hrow = (size_t)(b * 4 + h) * SEQ + t0 + tok;
    {   f32x4 acc[12]; zero_acc(acc);
        for (int kc = 0; kc < 3; ++kc) {
            __syncthreads();
            ld_tile<128, 128>(As, TS, H + row0 * HLD + C_ACQ + kc * 128, HLD, tid);
            ld_tile<192, 128>(Bs, TS, (const bf16_t*)(wsl + WS_WUQ) + ((size_t)l * 768 + h * 192) * 384 + kc * 128, 384, tid);
            __syncthreads();
            mma_slab<12, 4>(acc, As + (w * 16) * TS, TS, Bs, TS, lane);
        }
        const float rs = rsq[tok] * 0.07216878364870322f;
        bf16_t* o = (bf16_t*)(wsl + WS_QA) + hrow * 192 + q4;
#pragma unroll
        for (int t = 0; t < 8; ++t) { u32x2 v; v.x = pk2(acc[t][0] * rs, acc[t][1] * rs); v.y = pk2(acc[t][2] * rs, acc[t][3] * rs); *(u32x2*)(o + t * 16) = v; }
        const f32x2* tab = (const f32x2*)(wsl + WS_ROPE32) + (row0 + tok) * 32 + q4;
#pragma unroll
        for (int t2 = 0; t2 < 2; ++t2) { float o1[4], o2[4];
#pragma unroll
            for (int j = 0; j < 4; ++j) { const f32x2 cs_ = tab[t2 * 16 + j]; const float cs = cs_.x, s = cs_.y; const float x1 = acc[8 + t2][j] * rs, x2 = acc[10 + t2][j] * rs;
                o1[j] = x1 * cs - x2 * s; o2[j] = x2 * cs + x1 * s; }
            u32x2 v; v.x = pk2(o1[0], o1[1]); v.y = pk2(o1[2], o1[3]); *(u32x2*)(o + 128 + t2 * 16) = v;
            v.x = pk2(o2[0], o2[1]); v.y = pk2(o2[2], o2[3]); *(u32x2*)(o + 160 + t2 * 16) = v; } }
    __syncthreads();
    ld_tile<128, 128>(As, TS, H + row0 * HLD + C_ACKV, HLD, tid);
    ld_tile<256, 128>(Bs, TS, (const bf16_t*)(wsl + WS_WUKV) + ((size_t)l * 1024 + h * 256) * 128, 128, tid);
    __syncthreads();
    {   f32x4 acc[8]; zero_acc(acc);
        mma_slab<8, 4>(acc, As + (w * 16) * TS, TS, Bs, TS, lane);
        const float rs = rskv[tok]; bf16_t* o = (bf16_t*)(wsl + WS_KA) + hrow * 192 + q4;
#pragma unroll
        for (int t = 0; t < 8; ++t) { u32x2 v; v.x = pk2(acc[t][0] * rs, acc[t][1] * rs); v.y = pk2(acc[t][2] * rs, acc[t][3] * rs); *(u32x2*)(o + t * 16) = v; } }
    {   f32x4 acc[8]; zero_acc(acc);
        mma_slab_n<8, 4>(acc, As + (w * 16) * TS, TS, Bs + 128 * TS, TS, lane);
        const int tk = w * 16 + q4; const float r0 = rskv[tk], r1 = rskv[tk + 1], r2 = rskv[tk + 2], r3 = rskv[tk + 3];
        bf16_t* o = (bf16_t*)(wsl + WS_VAT) + ((size_t)(b * 4 + h) * 128 + (lane & 15)) * SEQ + t0 + tk;
#pragma unroll
        for (int t = 0; t < 8; ++t) { u32x2 v; v.x = pk2(acc[t][0] * r0, acc[t][1] * r1); v.y = pk2(acc[t][2] * r2, acc[t][3] * r3); *(u32x2*)(o + (size_t)t * 16 * SEQ) = v; } }
    for (int i = tid; i < 128 * 32; i += 512) { const int tk = i >> 5, k = i & 31; const f32x2 cs_ = ((const f32x2*)(wsl + WS_ROPE32))[row0 * 32 + i]; const float cs = cs_.x, s = cs_.y;
        const float* src = HS + (row0 + tk) * 256 + S_KPE; const float x1 = src[k], x2 = src[k + 32];
        bf16_t* o = (bf16_t*)(wsl + WS_KA) + ((size_t)(b * 4 + h) * SEQ + t0 + tk) * 192 + 128;
        o[k] = f2bf(x1 * cs - x2 * s); o[k + 32] = f2bf(x2 * cs + x1 * s); }
}

template <int DK, bool CAUSAL, bool VT_GLOBAL>
__device__ void attn_item(const Prm& p, LAS unsigned char* lds, const bf16_t* Q, size_t ldq, const bf16_t* K, size_t ldk, const bf16_t* V, size_t ldv,
                          int nkb, float sscale, size_t yrow0, int ycol, int tid) {
    asm volatile("" : "+v"(tid)); unsigned char* wsl = p.ws; asm volatile("" : "+s"(wsl));
    constexpr int KS = DK / 32, LQ = DK + 8;
    const int lane = tid & 63, w = tid >> 6;
    LAS bf16_t* Qs = (LAS bf16_t*)lds; LAS bf16_t* Ks = (LAS bf16_t*)(lds + 51200); LAS bf16_t* VT = (LAS bf16_t*)(lds + 102400);
    __syncthreads();
    ld_tile<128, DK>(Qs, LQ, Q, ldq, tid);
    __syncthreads();
    bf16x8 qf[KS];
#pragma unroll
    for (int ks = 0; ks < KS; ++ks) qf[ks] = *(const LAS bf16x8*)(Qs + (w * 16 + (lane & 15)) * LQ + ks * 32 + (lane >> 4) * 8);
    f32x4 O[8]; zero_acc(O);
    float m_run = -3.0e38f, l_run = 0.f;
    const int ql = w * 16 + (lane & 15), q4 = (lane >> 4) * 4;
    for (int kb = 0; kb < nkb; ++kb) {
        __syncthreads();
        ld_tile<128, DK>(Ks, LQ, K + (size_t)kb * 128 * ldk, ldk, tid);
        if (VT_GLOBAL) ld_tile<128, 128>(VT, TS, V + (size_t)kb * 128, ldv, tid);
        else ld_tile_T<128, 128>(VT, TS, V + (size_t)kb * 128 * ldv, ldv, tid);
        __syncthreads();
        f32x4 S[8]; zero_acc(S);
        mma_slab_ra<8, KS>(S, qf, Ks, LQ, lane);
        float mx = -3.0e38f;
#pragma unroll
        for (int t = 0; t < 8; ++t)
#pragma unroll
            for (int j = 0; j < 4; ++j) { float s = S[t][j] * sscale; if (CAUSAL && kb == nkb - 1 && (t * 16 + q4 + j) > ql) s = -3.0e38f; S[t][j] = s; mx = fmaxf(mx, s); }
        mx = rmax4(mx);
        const float m_new = fmaxf(m_run, mx), alpha = __expf(m_run - m_new);
        float rs = 0.f;
#pragma unroll
        for (int t = 0; t < 8; ++t) {
#pragma unroll
            for (int j = 0; j < 4; ++j) { const float e = __expf(S[t][j] - m_new); S[t][j] = e; rs += e; }
            u32x2 v; v.x = pk2(S[t][0], S[t][1]); v.y = pk2(S[t][2], S[t][3]);
            *(LAS u32x2*)(Qs + ql * TS + t * 16 + q4) = v; O[t] = O[t] * alpha; }
        l_run = l_run * alpha + rsum4(rs); m_run = m_new;
        __syncthreads();
        mma_slab<8, 4>(O, Qs + (w * 16) * TS, TS, VT, TS, lane);
    }
    const float inv = 1.0f / l_run;
    const bf16_t* zp = (const bf16_t*)(wsl + WS_H) + (yrow0 + ql) * HLD + C_Z + ycol + q4;
    bf16_t* yp = (bf16_t*)(wsl + WS_Y) + (yrow0 + ql) * DM + ycol + q4;
#pragma unroll
    for (int t = 0; t < 8; ++t) { const u32x2 z = *(const u32x2*)(zp + t * 16);
        u32x2 v; v.x = pk2(O[t][0] * inv * siluf(lo16(z.x)), O[t][1] * inv * siluf(hi16(z.x))); v.y = pk2(O[t][2] * inv * siluf(lo16(z.y)), O[t][3] * inv * siluf(hi16(z.y)));
        *(u32x2*)(yp + t * 16) = v; }
}

__device__ void ret_out(const Prm& p, LAS unsigned char* lds, int l, int idx, int tid) {
    asm volatile("" : "+v"(tid)); unsigned char* wsl = p.ws; asm volatile("" : "+s"(wsl));
    const int c = idx & 15, h = (idx >> 4) & 3, b = idx >> 6, lane = tid & 63, w = tid >> 6;
    const size_t row0 = (size_t)b * SEQ + c * 128;
    const bf16_t* H = (const bf16_t*)(wsl + WS_H);
    LAS bf16_t* Qs = (LAS bf16_t*)lds; LAS bf16_t* Ks = (LAS bf16_t*)(lds + REG); LAS bf16_t* VT = (LAS bf16_t*)(lds + 2 * REG); LAS bf16_t* ST = (LAS bf16_t*)(lds + 3 * REG);
    const float lg2 = ret_log2g(h);
    __syncthreads();
    ld_tile<128, 128>(Qs, TS, H + row0 * HLD + C_RQ + h * 128, HLD, tid);
    ld_tile<128, 128>(Ks, TS, H + row0 * HLD + C_RK + h * 128, HLD, tid);
    ld_tile_T<128, 128>(VT, TS, H + row0 * HLD + C_RV + h * 128, HLD, tid);
    {   float a[4][8];
#pragma unroll
        for (int i = 0; i < 4; ++i)
#pragma unroll
            for (int e = 0; e < 8; ++e) a[i][e] = 0.f;
        const bf16_t* U0 = (const bf16_t*)(wsl + WS_URT) + (size_t)(idx - c) * 16384;
        for (int j = 0; j < c; ++j) { const float wj = exp2f(lg2 * 128.f * (float)(c - 1 - j));
#pragma unroll
            for (int i = 0; i < 4; ++i) { const u32x4 v = *(const u32x4*)(U0 + (size_t)j * 16384 + (tid + 512 * i) * 8);
                a[i][0] += wj * lo16(v.x); a[i][1] += wj * hi16(v.x); a[i][2] += wj * lo16(v.y); a[i][3] += wj * hi16(v.y);
                a[i][4] += wj * lo16(v.z); a[i][5] += wj * hi16(v.z); a[i][6] += wj * lo16(v.w); a[i][7] += wj * hi16(v.w); } }
#pragma unroll
        for (int i = 0; i < 4; ++i) { const int off = (tid + 512 * i) * 8, dv = off >> 7, dk = off & 127;
            u32x4 o; o.x = pk2(a[i][0], a[i][1]); o.y = pk2(a[i][2], a[i][3]); o.z = pk2(a[i][4], a[i][5]); o.w = pk2(a[i][6], a[i][7]);
            *(LAS u32x4*)(ST + dv * TS + dk) = o; } }
    __syncthreads();
    rope_lds<64>(Qs, TS, 0, (const f32x2*)(wsl + WS_ROPE64) + row0 * 64, 1.0f, tid);
    rope_lds<64>(Ks, TS, 0, (const f32x2*)(wsl + WS_ROPE64) + row0 * 64, 0.08838834764831845f, tid);
    __syncthreads();
    const int ql = w * 16 + (lane & 15), q4 = (lane >> 4) * 4;
    f32x4 S[8]; zero_acc(S);
    mma_slab<8, 4>(S, Qs + (w * 16) * TS, TS, Ks, TS, lane);
    __syncthreads();
#pragma unroll
    for (int t = 0; t < 8; ++t) {
#pragma unroll
        for (int j = 0; j < 4; ++j) { const int rel = ql - (t * 16 + q4 + j); S[t][j] = rel >= 0 ? S[t][j] * exp2f(lg2 * (float)rel) : 0.f; }
        u32x2 v; v.x = pk2(S[t][0], S[t][1]); v.y = pk2(S[t][2], S[t][3]); *(LAS u32x2*)(Ks + ql * TS + t * 16 + q4) = v; }
    __syncthreads();
    f32x4 O[8]; zero_acc(O);
    mma_slab<8, 4>(O, Ks + (w * 16) * TS, TS, VT, TS, lane);
    f32x4 O2[8]; zero_acc(O2);
    mma_slab<8, 4>(O2, Qs + (w * 16) * TS, TS, ST, TS, lane);
    const float dq = exp2f(lg2 * (float)(ql + 1));
#pragma unroll
    for (int t = 0; t < 8; ++t) O[t] = O[t] + O2[t] * dq;
    head_norm(O);
    const float* g = p.ret_norm_g + l * 512 + h * 128 + q4;
    const bf16_t* zp = H + (row0 + ql) * HLD + C_Z + h * 128 + q4;
    bf16_t* yp = (bf16_t*)(wsl + WS_Y) + (row0 + ql) * DM + h * 128 + q4;
#pragma unroll
    for (int t = 0; t < 8; ++t) { const u32x2 z = *(const u32x2*)(zp + t * 16); const f32x4 gv = *(const f32x4*)(g + t * 16);
        u32x2 v; v.x = pk2(O[t][0] * gv[0] * siluf(lo16(z.x)), O[t][1] * gv[1] * siluf(hi16(z.x))); v.y = pk2(O[t][2] * gv[2] * siluf(lo16(z.y)), O[t][3] * gv[3] * siluf(hi16(z.y)));
        *(u32x2*)(yp + t * 16) = v; }
}

__device__ void mlstm_out(const Prm& p, LAS unsigned char* lds, int l, int idx, int tid) {
    asm volatile("" : "+v"(tid)); unsigned char* wsl = p.ws; asm volatile("" : "+s"(wsl));
    const int c = idx & 15, h = (idx >> 4) & 3, b = idx >> 6, lane = tid & 63, w = tid >> 6;
    const size_t row0 = (size_t)b * SEQ + c * 128;
    const bf16_t* H = (const bf16_t*)(wsl + WS_H); const float* HS = (const float*)(wsl + WS_HS);
    LAS bf16_t* Qs = (LAS bf16_t*)lds; LAS bf16_t* Ks = (LAS bf16_t*)(lds + REG); LAS bf16_t* VT = (LAS bf16_t*)(lds + 2 * REG); LAS bf16_t* ST = (LAS bf16_t*)(lds + 3 * REG);
    LAS float* lf = (LAS float*)(lds + MISC_OFF); LAS float* ag = lf + 128; LAS float* Mx = lf + 256; LAS float* wint = lf + 384; LAS float* em = lf + 512; LAS float* nst = lf + 640;
    const float* gsc = (const float*)(wsl + WS_GSC) + (size_t)(idx - c) * 2;
    float G = 0.f, Mref = 0.f;
    for (int j = 0; j < c; ++j) { Mref = fmaxf(Mref, gsc[2 * j + 1] - G); G += gsc[2 * j]; }
    __syncthreads();
    const float lfv = tid < 128 ? logsig(HS[(row0 + tid) * 256 + S_LF + h] + p.ml_f_bias[l * 4 + h]) : 0.f;
    const float ipv = tid < 128 ? HS[(row0 + tid) * 256 + S_LI + h] + p.ml_i_bias[l * 4 + h] : 0.f;
    const size_t hb0 = ((size_t)(b * 4 + h) * SEQ + c * 128) * 128;
    ld_tile<128, 128>(Qs, TS, (const bf16_t*)(wsl + WS_LQ) + hb0, 128, tid);
    ld_tile<128, 128>(Ks, TS, (const bf16_t*)(wsl + WS_LK) + hb0, 128, tid);
    ld_tile_T<128, 128>(VT, TS, H + row0 * HLD + C_LV + h * 128, HLD, tid);
    {   float a[4][8]; float nacc = 0.f;
#pragma unroll
        for (int i = 0; i < 4; ++i)
#pragma unroll
            for (int e = 0; e < 8; ++e) a[i][e] = 0.f;
        const bf16_t* U0 = (const bf16_t*)(wsl + WS_ULT) + (size_t)(idx - c) * 16384; const float* NV0 = (const float*)(wsl + WS_NV) + (size_t)(idx - c) * 128;
        float G2 = 0.f;
        for (int j = 0; j < c; ++j) { const float wj = expf(gsc[2 * j + 1] - G2 - Mref); G2 += gsc[2 * j];
            if (tid < 128) nacc += wj * NV0[j * 128 + tid];
#pragma unroll
            for (int i = 0; i < 4; ++i) { const u32x4 v = *(const u32x4*)(U0 + (size_t)j * 16384 + (tid + 512 * i) * 8);
                a[i][0] += wj * lo16(v.x); a[i][1] += wj * hi16(v.x); a[i][2] += wj * lo16(v.y); a[i][3] += wj * hi16(v.y);
                a[i][4] += wj * lo16(v.z); a[i][5] += wj * hi16(v.z); a[i][6] += wj * lo16(v.w); a[i][7] += wj * hi16(v.w); } }
        if (tid < 128) nst[tid] = nacc;
#pragma unroll
        for (int i = 0; i < 4; ++i) { const int off = (tid + 512 * i) * 8, dv = off >> 7, dk = off & 127;
            u32x4 o; o.x = pk2(a[i][0], a[i][1]); o.y = pk2(a[i][2], a[i][3]); o.z = pk2(a[i][4], a[i][5]); o.w = pk2(a[i][6], a[i][7]);
            *(LAS u32x4*)(ST + dv * TS + dk) = o; } }
    __syncthreads();
    const float cum = scan128_sum(lfv, lf, tid);
    const float agv = tid < 128 ? ipv - cum - G : -3.0e38f;
    float mtot; const float mxs = scan128_max(agv, lf, tid, mtot);
    if (tid < 128) { const float mx = fmaxf(Mref, mxs); ag[tid] = agv;
        Mx[tid] = mx; wint[tid] = expf(Mref - mx); em[tid] = expf(-(G + cum + mx)); }
    __syncthreads();
    const int ql = w * 16 + (lane & 15), q4 = (lane >> 4) * 4;
    f32x4 S[8]; zero_acc(S);
    mma_slab<8, 4>(S, Qs + (w * 16) * TS, TS, Ks, TS, lane);
    const float mq = Mx[ql]; float den = 0.f;
    __syncthreads();
#pragma unroll
    for (int t = 0; t < 8; ++t) {
#pragma unroll
        for (int j = 0; j < 4; ++j) { const int key = t * 16 + q4 + j; const float sv = key <= ql ? S[t][j] * expf(ag[key] - mq) : 0.f; S[t][j] = sv; den += sv; }
        u32x2 v; v.x = pk2(S[t][0], S[t][1]); v.y = pk2(S[t][2], S[t][3]); *(LAS u32x2*)(Ks + ql * TS + t * 16 + q4) = v; }
    den = rsum4(den);
    float qn = 0.f;
#pragma unroll
    for (int i = 0; i < 32; ++i) qn += bf2f(Qs[ql * TS + q4 * 8 + i]) * nst[q4 * 8 + i];
    qn = rsum4(qn);
    __syncthreads();
    f32x4 O[8]; zero_acc(O);
    mma_slab<8, 4>(O, Ks + (w * 16) * TS, TS, VT, TS, lane);
    f32x4 O2[8]; zero_acc(O2);
    mma_slab<8, 4>(O2, Qs + (w * 16) * TS, TS, ST, TS, lane);
    const float wi = wint[ql]; den += wi * qn;
    const float invd = 1.0f / fmaxf(fabsf(den), em[ql]);
    const bf16_t* lop = H + (row0 + ql) * HLD + C_LO + h * 128 + q4;
#pragma unroll
    for (int t = 0; t < 8; ++t) { const u32x2 lo = *(const u32x2*)(lop + t * 16);
        O[t] = (O[t] + O2[t] * wi) * invd;
        O[t][0] *= sigmf(lo16(lo.x)); O[t][1] *= sigmf(hi16(lo.x)); O[t][2] *= sigmf(lo16(lo.y)); O[t][3] *= sigmf(hi16(lo.y)); }
    head_norm(O);
    const float* g = p.ml_norm_g + l * 512 + h * 128 + q4; const float* sk = p.ml_skip + l * 512 + h * 128 + q4;
    const bf16_t* xcp = (const bf16_t*)(wsl + WS_XC) + (row0 + ql) * 512 + h * 128 + q4;
    const bf16_t* zp = H + (row0 + ql) * HLD + C_Z + 1024 + h * 128 + q4;
    bf16_t* yp = (bf16_t*)(wsl + WS_Y) + (row0 + ql) * DM + 1024 + h * 128 + q4;
#pragma unroll
    for (int t = 0; t < 8; ++t) { const u32x2 z = *(const u32x2*)(zp + t * 16), xc = *(const u32x2*)(xcp + t * 16); const f32x4 gv = *(const f32x4*)(g + t * 16), sv = *(const f32x4*)(sk + t * 16);
        const float y0 = (O[t][0] * gv[0] + sv[0] * lo16(xc.x)) * siluf(lo16(z.x)), y1 = (O[t][1] * gv[1] + sv[1] * hi16(xc.x)) * siluf(hi16(z.x));
        const float y2 = (O[t][2] * gv[2] + sv[2] * lo16(xc.y)) * siluf(lo16(z.y)), y3 = (O[t][3] * gv[3] + sv[3] * hi16(xc.y)) * siluf(hi16(z.y));
        u32x2 v; v.x = pk2(y0, y1); v.y = pk2(y2, y3); *(u32x2*)(yp + t * 16) = v; }
}

__device__ void ln_pass(const Prm& p, int l, int tid, int bid, int nb) {
    asm volatile("" : "+v"(tid)); unsigned char* wsl = p.ws; asm volatile("" : "+s"(wsl));
    const int lane = tid & 63, w = tid >> 6; float* T = p.out; bf16_t* XN = (bf16_t*)(wsl + WS_XN);
    const float* g = p.ln_g + l * DM; const float* bb = p.ln_b + l * DM;
    for (int row = bid * 8 + w; row < NTOK; row += nb * 8) { float* rp = T + (size_t)row * DM + lane * 4;
        f32x4 v[8]; float s = 0.f;
#pragma unroll
        for (int i = 0; i < 8; ++i) { v[i] = *(const f32x4*)(rp + i * 256); s += (v[i][0] + v[i][1]) + (v[i][2] + v[i][3]); }
#pragma unroll
        for (int o = 1; o < 64; o <<= 1) s += __shfl_xor(s, o);
        const float mean = s * (1.0f / DM); float q = 0.f;
#pragma unroll
        for (int i = 0; i < 8; ++i) { v[i] = v[i] - mean; q += (v[i][0] * v[i][0] + v[i][1] * v[i][1]) + (v[i][2] * v[i][2] + v[i][3] * v[i][3]); }
#pragma unroll
        for (int o = 1; o < 64; o <<= 1) q += __shfl_xor(q, o);
        const float rstd = rsqrtf(q * (1.0f / DM) + 1e-5f);
#pragma unroll
        for (int i = 0; i < 8; ++i) { const f32x4 gv = *(const f32x4*)(g + lane * 4 + i * 256), bv = *(const f32x4*)(bb + lane * 4 + i * 256);
            const f32x4 y = v[i] * rstd * gv + bv; *(f32x4*)(rp + i * 256) = y;
            u32x2 o; o.x = pk2(y[0], y[1]); o.y = pk2(y[2], y[3]); *(u32x2*)(XN + (size_t)row * DM + lane * 4 + i * 256) = o; } }
}

__device__ __forceinline__ int pair16(int k) { return k < 256 ? (k & 31) * 16 + (k >> 5) : (k & 31) * 16 + 15 - ((k - 256) >> 5); }

__global__ void __launch_bounds__(512, 2) fwd_kernel(Prm p) {
    extern __shared__ __attribute__((aligned(16))) unsigned char lds_raw[];
    LAS unsigned char* lds = (LAS unsigned char*)lds_raw;
    const int tid = threadIdx.x, bid = blockIdx.x, nb = gridDim.x;
#ifndef PROBE_REP
#define PROBE_REP -1
#endif
    for (int ph2 = p.ph_lo * 2; ph2 < p.ph_hi * 2; ++ph2) {
        const int ph = ph2 >> 1;
        if (ph2 & 1) { const bool rep = (PROBE_REP == 9 && ph == 0) || (PROBE_REP >= 0 && PROBE_REP < 3 && ph > 0 && (ph - 1) % 5 == PROBE_REP); if (!rep) continue; }
#ifndef PROBE_MASK
#define PROBE_MASK 127
#endif
        const int tmask = (ph2 & 1) ? PROBE_MASK : 127;
        unsigned char* ws = p.ws; asm volatile("" : "+s"(ws));
#ifndef NO_P0
        if (ph == 0) phase0(p, lds, tid, bid, nb);
#else
        if (ph == 0) {}
#endif
        else {
            const int l = (ph - 1) / 5, sub = (ph - 1) % 5;
            if (sub == 0) {
#ifndef NO_G1
                {   pg8::Gemm g{(const pg8::bf16_t*)(ws + WS_XN), (const pg8::bf16_t*)(ws + WS_WIN) + (size_t)l * NIN * DM, NTOK, NIN, DM};
                    pg8::StaticOrder S; S.init(NTOK, NIN, nb, bid);
                    EpiH E{(bf16_t*)(ws + WS_H), (float*)(ws + WS_HS)};
                    pg8::gemm_phase<EpiH, pg8::StaticOrder>(lds, g, S, E, nullptr); }
                {   pg8::Gemm g{(const pg8::bf16_t*)(ws + WS_MEMB), (const pg8::bf16_t*)(ws + WS_WMEM) + (size_t)l * 1024 * DM, 2048, 1024, DM};
                    pg8::StaticOrder S; S.init(2048, 1024, nb, (bid + nb - 64 % nb) % nb);
                    pg8::EpiBf16<0> E{(pg8::bf16_t*)(ws + WS_MKV), 1024, nullptr, 0, 0};
                    pg8::gemm_phase<pg8::EpiBf16<0>, pg8::StaticOrder>(lds, g, S, E, nullptr); }
#endif
            } else if (sub == 1) {
#ifndef NO_2A
                for (int i = bid; i < 2048; i += nb) { const int ty = i >> 9, k = i & 511;
                    if (ty == 0) { if (tmask & 1) ret_state(p, lds, k, tid); }
                    else if (ty == 1) { if (tmask & 2) mlstm_state(p, lds, l, k, tid); }
                    else if (ty == 2) { if (tmask & 4) mla_proj(p, lds, l, k, tid); }
                    else if (tmask & 8) { const int h = k & 3, qb = (k >> 2) & 15, b = k >> 6; const bf16_t* MKV = (const bf16_t*)(ws + WS_MKV);
                        attn_item<128, false, false>(p, lds, (const bf16_t*)(ws + WS_H) + ((size_t)b * SEQ + qb * 128) * HLD + C_CQ + h * 128, HLD,
                            MKV + (size_t)b * 256 * 1024 + h * 128, 1024, MKV + (size_t)b * 256 * 1024 + 512 + h * 128, 1024, 2, 0.08838834764831845f, (size_t)b * SEQ + qb * 128, 1536 + h * 128, tid); } }
#endif
            } else if (sub == 2) {
#ifndef NO_2B
                for (int i = bid; i < 1536; i += nb) { const int ty = i >> 9, k = i & 511; const int idx = pair16(k);
                    if (ty == 0) { if (tmask & 16) ret_out(p, lds, l, idx, tid); }
                    else if (ty == 1) { if (tmask & 32) mlstm_out(p, lds, l, idx, tid); }
                    else if (tmask & 64) { const int qb = idx & 15, bh = idx >> 4, b = bh >> 2, h = bh & 3;
                        attn_item<192, true, true>(p, lds, (const bf16_t*)(ws + WS_QA) + ((size_t)bh * SEQ + qb * 128) * 192, 192, (const bf16_t*)(ws + WS_KA) + (size_t)bh * SEQ * 192, 192,
                            (const bf16_t*)(ws + WS_VAT) + (size_t)bh * 128 * SEQ, SEQ, qb + 1, 1.0f, (size_t)b * SEQ + qb * 128, 512 + h * 128, tid); } }
#endif
            } else if (sub == 3) {
#ifndef NO_G2
                pg8::Gemm g{(const pg8::bf16_t*)(ws + WS_Y), (const pg8::bf16_t*)(ws + WS_WOUT) + (size_t)l * DM * DM, NTOK, DM, DM};
                pg8::StaticOrder S; S.init(NTOK, DM, nb, bid);
                EpiRes E{l == 0 ? p.x : p.out, p.out, 1.6817928305074290f};
                pg8::gemm_phase<EpiRes, pg8::StaticOrder>(lds, g, S, E, nullptr);
#endif
            } else {
#ifndef NO_LN
                ln_pass(p, l, tid, bid, nb);
#endif
            }
        }
        if (ph + 1 < p.ph_hi) cg::this_grid().sync();
    }
}

extern "C" void kernel_launch(void* const* d_in, const int* in_sizes, int n_in, void* d_out, int out_size, void* d_ws, size_t ws_size, hipStream_t stream) {
    static int grid = 0;
    if (grid == 0) {
        int dev = 0, cus = 0, per_cu = 0;
        hipGetDevice(&dev); hipDeviceGetAttribute(&cus, hipDeviceAttributeMultiprocessorCount, dev);
        if (hipFuncSetAttribute((const void*)fwd_kernel, hipFuncAttributeMaxDynamicSharedMemorySize, LDS_BYTES) != hipSuccess) fprintf(stderr, "kernel_launch: hipFuncSetAttribute failed\n");
        if (hipOccupancyMaxActiveBlocksPerMultiprocessor(&per_cu, (const void*)fwd_kernel, 512, LDS_BYTES) != hipSuccess || per_cu < 1) { fprintf(stderr, "kernel_launch: occupancy query says %d\n", per_cu); per_cu = 1; }
        (void)hipGetLastError();
        grid = cus * 1;
        if (ws_size < WS_END) fprintf(stderr, "kernel_launch: workspace too small: %zu < %zu\n", ws_size, (size_t)WS_END);
    }
    Prm p{};
    p.x = (const float*)d_in[0]; p.mem = (const float*)d_in[1]; p.pos = (const int*)d_in[2];
    p.w_in = (const float*)d_in[3]; p.ret_norm_g = (const float*)d_in[4]; p.mla_q_norm_g = (const float*)d_in[5]; p.mla_w_uq = (const float*)d_in[6]; p.mla_kv_norm_g = (const float*)d_in[7]; p.mla_w_ukv = (const float*)d_in[8];
    p.ml_conv_w = (const float*)d_in[9]; p.ml_conv_b = (const float*)d_in[10]; p.ml_w_q = (const float*)d_in[11]; p.ml_w_k = (const float*)d_in[12]; p.ml_i_bias = (const float*)d_in[13]; p.ml_f_bias = (const float*)d_in[14];
    p.ml_skip = (const float*)d_in[15]; p.ml_norm_g = (const float*)d_in[16]; p.w_mem_kv = (const float*)d_in[17]; p.w_out = (const float*)d_in[18]; p.ln_g = (const float*)d_in[19]; p.ln_b = (const float*)d_in[20];
    p.out = (float*)d_out; p.ws = (unsigned char*)d_ws;
#if N_LAUNCH_MODE == 1
    p.ph_lo = 0; p.ph_hi = NPHASE;
    void* args[] = {&p};
    hipError_t e = hipLaunchCooperativeKernel((const void*)fwd_kernel, dim3(grid), dim3(512), args, LDS_BYTES, stream);
    if (e != hipSuccess) fprintf(stderr, "cooperative launch failed: %s (grid %d)\n", hipGetErrorString(e), grid);
#else
    for (int ph = 0; ph < NPHASE; ++ph) { p.ph_lo = ph; p.ph_hi = ph + 1;
        hipLaunchKernelGGL(fwd_kernel, dim3(grid), dim3(512), LDS_BYTES, stream, p); }
#endif
}
```
